# Optimizing an MI355X kernel written in HIP

```python
import math
import jax, jax.numpy as jnp
from jax import lax
import numpy as np

D_MODEL = 1024
BATCH = 1
SEQ = 16384
DEPTH = 2

N_HEADS_A = 8
HEAD_DIM_A = 64
D_A = N_HEADS_A * HEAD_DIM_A
ATTN_PATTERNS = ((128, 1), (512, 4), (2048, 16))
ATTN_BLOCK = 128
NUM_BUCKETS = 32
MAX_DISTANCE = 2048
N_HEADS_M = 4
HEAD_DIM_M = 128
D_M = N_HEADS_M * HEAD_DIM_M
CONV_K = 4
MLSTM_CHUNK = 128
P_IN = 3 * D_A + 2 * D_M
D_FF = 2816
N_EXPERTS = 8
TOP_K = 2
D_FF_E = 3584
N_DENSE = (DEPTH + 1) // 2
N_MOE = DEPTH // 2
ALPHA = (2.0 * DEPTH) ** 0.25
BETA = (8.0 * DEPTH) ** -0.25
LN_EPS = 1e-5

kernel_name = "hybrid_dilated_attn_mlstm_moe_deepnorm"


def layer_norm(x, g, b):
    xf = x.astype(jnp.float32)
    mu = xf.mean(-1, keepdims=True)
    var = jnp.square(xf - mu).mean(-1, keepdims=True)
    return ((xf - mu) * lax.rsqrt(var + LN_EPS) * g.astype(jnp.float32) + b.astype(jnp.float32)).astype(x.dtype)


def rel_bucket(dist):
    exact = NUM_BUCKETS // 2
    d = jnp.maximum(dist, exact).astype(jnp.float32)
    log_b = exact + (jnp.log(d / exact) / math.log(MAX_DISTANCE / exact) * (NUM_BUCKETS - exact)).astype(jnp.int32)
    return jnp.where(dist < exact, dist, jnp.minimum(log_b, NUM_BUCKETS - 1))


def strided_window_attention(q, k, v, rel_bias, window, dilation):
    B, S, H, hd = q.shape
    L = S // dilation
    W = window // dilation
    blk = ATTN_BLOCK
    nb = -(-L // blk)
    Lp = nb * blk

    def to_classes(t):
        t = t.reshape(B, L, dilation, H, hd).transpose(0, 2, 1, 3, 4).reshape(B * dilation, L, H, hd)
        return jnp.pad(t, ((0, 0), (0, Lp - L), (0, 0), (0, 0)))

    qc, kc, vc = to_classes(q), to_classes(k), to_classes(v)
    qb = qc.reshape(B * dilation, nb, blk, H, hd)

    def band(t):
        t = jnp.pad(t, ((0, 0), (blk, 0), (0, 0), (0, 0))).reshape(B * dilation, nb + 1, blk, H, hd)
        return jnp.concatenate([t[:, :-1], t[:, 1:]], axis=2)

    kb, vb = band(kc), band(vc)
    qi = jnp.arange(blk)[:, None]
    kj = jnp.arange(2 * blk)[None, :]
    rel = qi + blk - kj
    bias = rel_bias[rel_bucket(jnp.maximum(rel, 0) * dilation)]
    bias = bias.transpose(2, 0, 1).astype(jnp.float32)
    key_pos = jnp.arange(nb)[:, None] * blk - blk + kj
    mask = ((rel >= 0) & (rel <= W))[None] & (key_pos >= 0)[:, None, :]

    logits = jnp.einsum('bnqhd,bnkhd->bnhqk', qb.astype(jnp.float32), kb.astype(jnp.float32)) * (hd ** -0.5) + bias
    logits = jnp.where(mask[None, :, None], logits, -jnp.inf)
    m = logits.max(-1, keepdims=True)
    p = jnp.exp(logits - m)
    denom = p.sum(-1, keepdims=True)
    o = jnp.einsum('bnhqk,bnkhd->bnqhd', p / denom, vb.astype(jnp.float32))
    lse = (m + jnp.log(denom))[..., 0].transpose(0, 1, 3, 2)

    def from_classes(t):
        t = t.reshape((B * dilation, Lp) + t.shape[3:])[:, :L]
        t = t.reshape((B, dilation, L) + t.shape[2:])
        t = jnp.moveaxis(t, 1, 2)
        return t.reshape((B, S) + t.shape[3:])

    return from_classes(o), from_classes(lse)


def dilated_attention(q, k, v, rel_bias):
    outs, lses = [], []
    for window, dilation in ATTN_PATTERNS:
        o, lse = strided_window_attention(q, k, v, rel_bias, window, dilation)
        outs.append(o)
        lses.append(lse)
    wts = jax.nn.softmax(jnp.stack(lses), axis=0)
    return jnp.einsum('pbsh,pbshd->bshd', wts, jnp.stack(outs))


def mlstm_chunkwise(q, k, v, i_pre, log_f):
    B, S, H, hd = q.shape
    L = MLSTM_CHUNK
    nc = S // L
    k = k * (hd ** -0.5)
    tri = jnp.tril(jnp.ones((L, L), dtype=bool))

    def chunks(t):
        return jnp.moveaxis(t.reshape((B, nc, L) + t.shape[2:]), 1, 0)

    def step(carry, xs):
        C, n, m = carry
        qc, kc, vc, ic, fc = xs
        b = jnp.cumsum(fc, axis=1).transpose(0, 2, 1)
        ic = ic.transpose(0, 2, 1)
        Dm = jnp.where(tri, b[..., :, None] - b[..., None, :] + ic[..., None, :], -jnp.inf)
        inter = b + m[..., None]
        m_loc = jnp.maximum(inter, Dm.max(-1))
        Dexp = jnp.exp(Dm - m_loc[..., None])
        inter_w = jnp.exp(inter - m_loc)
        s = jnp.einsum('blhd,bshd->bhls', qc, kc) * Dexp
        num = inter_w[..., None] * jnp.einsum('blhd,bhde->bhle', qc, C) + jnp.einsum('bhls,bshe->bhle', s, vc)
        nq = inter_w * jnp.einsum('blhd,bhd->bhl', qc, n) + s.sum(-1)
        h = num / jnp.maximum(jnp.abs(nq), jnp.exp(-m_loc))[..., None]
        bL = b[..., -1]
        g = bL[..., None] - b + ic
        m_new = jnp.maximum(bL + m, g.max(-1))
        decay = jnp.exp(bL + m - m_new)
        w = jnp.exp(g - m_new[..., None])
        C = decay[..., None, None] * C + jnp.einsum('bhs,bshd,bshe->bhde', w, kc, vc)
        n = decay[..., None] * n + jnp.einsum('bhs,bshd->bhd', w, kc)
        return (C, n, m_new), h.transpose(0, 2, 1, 3)

    init = (jnp.zeros((B, H, hd, hd), jnp.float32), jnp.zeros((B, H, hd), jnp.float32),
            jnp.zeros((B, H), jnp.float32))
    _, hs = lax.scan(step, init, (chunks(q), chunks(k), chunks(v), chunks(i_pre), chunks(log_f)))
    return jnp.moveaxis(hs, 0, 1).reshape(B, S, H, hd)


def causal_conv(x, w, b):
    out = lax.conv_general_dilated(x, w[:, None, :].astype(x.dtype), window_strides=(1,),
                                   padding=[(CONV_K - 1, 0)], dimension_numbers=('NWC', 'WIO', 'NWC'),
                                   feature_group_count=x.shape[-1])
    return out + b


def token_mixer(x, rel_bias, w_in, w_gate, b_gate, conv_w, conv_b, w_qk_m, w_v_m, w_if, b_if,
                m_norm_g, w_br_a, w_br_m, w_o):
    B, S, _ = x.shape
    proj = x @ w_in
    q_a, k_a, v_a, x_m, z_m = jnp.split(proj, [D_A, 2 * D_A, 3 * D_A, 3 * D_A + D_M], axis=-1)

    ha = lambda t: t.reshape(B, S, N_HEADS_A, HEAD_DIM_A)
    y_a = dilated_attention(ha(q_a), ha(k_a), ha(v_a), rel_bias).reshape(B, S, D_A).astype(x.dtype)

    hm = lambda t: t.reshape(B, S, N_HEADS_M, HEAD_DIM_M)
    x_c = jax.nn.silu(causal_conv(x_m, conv_w, conv_b))
    q_m = jnp.einsum('bshd,hde->bshe', hm(x_c), w_qk_m[0])
    k_m = jnp.einsum('bshd,hde->bshe', hm(x_c), w_qk_m[1])
    v_m = jnp.einsum('bshd,hde->bshe', hm(x_m), w_v_m)
    qkv = jnp.concatenate([q_m.reshape(B, S, D_M), k_m.reshape(B, S, D_M), v_m.reshape(B, S, D_M)], axis=-1)
    gates = (qkv @ w_if + b_if).astype(jnp.float32)
    i_pre, f_pre = jnp.split(gates, 2, axis=-1)
    f32 = lambda t: t.astype(jnp.float32)
    h = mlstm_chunkwise(f32(q_m), f32(k_m), f32(v_m), i_pre, jax.nn.log_sigmoid(f_pre))
    mu = h.mean(-1, keepdims=True)
    var = jnp.square(h - mu).mean(-1, keepdims=True)
    h = ((h - mu) * lax.rsqrt(var + LN_EPS)).reshape(B, S, D_M) * m_norm_g.astype(jnp.float32)
    y_m = (jax.nn.sigmoid(f32(z_m)) * h).astype(x.dtype)

    g_a, g_m = jnp.split(jax.nn.sigmoid(x @ w_gate + b_gate), 2, axis=-1)
    merged = g_a * (y_a @ w_br_a) + g_m * (y_m @ w_br_m)
    return merged @ w_o


def swiglu(x, w13, w2):
    a, g = jnp.split(x @ w13, 2, axis=-1)
    return (jax.nn.silu(a) * g) @ w2


def moe_ffn(x, router_w, router_b, w13, w2):
    logits = (x @ router_w).astype(jnp.float32) + router_b.astype(jnp.float32)
    top_v, top_i = lax.top_k(logits, TOP_K)
    wts = jax.nn.softmax(top_v, axis=-1)
    gate = jnp.einsum('bsk,bske->bse', wts, jax.nn.one_hot(top_i, N_EXPERTS, dtype=jnp.float32)).astype(x.dtype)
    y = jnp.zeros_like(x)
    for e in range(N_EXPERTS):
        y = y + gate[..., e:e + 1] * swiglu(x, w13[e], w2[e])
    return y


def setup_inputs(seed: int = 0) -> dict:
    key = jax.random.key(seed)
    ks = jax.random.split(key, 24)
    nrm = lambda k, shape, scale: jax.random.normal(k, shape, jnp.float32) * scale
    b_if = jnp.concatenate([nrm(ks[10], (DEPTH, N_HEADS_M), 0.1),
                            3.0 + 3.0 * jax.random.uniform(ks[11], (DEPTH, N_HEADS_M), jnp.float32)], axis=-1)
    return {
        "x": nrm(ks[0], (BATCH, SEQ, D_MODEL), 1.0),
        "rel_bias": nrm(ks[1], (NUM_BUCKETS, N_HEADS_A), 0.2),
        "w_in": nrm(ks[2], (DEPTH, D_MODEL, P_IN), D_MODEL ** -0.5),
        "w_gate": nrm(ks[3], (DEPTH, D_MODEL, 2 * D_MODEL), D_MODEL ** -0.5),
        "b_gate": nrm(ks[4], (DEPTH, 2 * D_MODEL), 0.02),
        "conv_w": nrm(ks[5], (DEPTH, CONV_K, D_M), CONV_K ** -0.5),
        "conv_b": nrm(ks[6], (DEPTH, D_M), 0.02),
        "w_qk_m": nrm(ks[7], (DEPTH, 2, N_HEADS_M, HEAD_DIM_M, HEAD_DIM_M), HEAD_DIM_M ** -0.5),
        "w_v_m": nrm(ks[8], (DEPTH, N_HEADS_M, HEAD_DIM_M, HEAD_DIM_M), HEAD_DIM_M ** -0.5),
        "w_if": nrm(ks[9], (DEPTH, 3 * D_M, 2 * N_HEADS_M), (3 * D_M) ** -0.5),
        "b_if": b_if,
        "m_norm_g": 1.0 + nrm(ks[12], (DEPTH, D_M), 0.02),
        "w_br_a": nrm(ks[13], (DEPTH, D_A, D_MODEL), D_A ** -0.5),
        "w_br_m": nrm(ks[14], (DEPTH, D_M, D_MODEL), D_M ** -0.5),
        "w_o": nrm(ks[15], (DEPTH, D_MODEL, D_MODEL), BETA * D_MODEL ** -0.5),
        "ln_g": 1.0 + nrm(ks[16], (DEPTH, 2, D_MODEL), 0.02),
        "ln_b": nrm(ks[17], (DEPTH, 2, D_MODEL), 0.02),
        "ffn_w13": nrm(ks[18], (N_DENSE, D_MODEL, 2 * D_FF), D_MODEL ** -0.5),
        "ffn_w2": nrm(ks[19], (N_DENSE, D_FF, D_MODEL), BETA * D_FF ** -0.5),
        "router_w": nrm(ks[20], (N_MOE, D_MODEL, N_EXPERTS), D_MODEL ** -0.5),
        "router_b": nrm(ks[21], (N_MOE, N_EXPERTS), 0.01),
        "exp_w13": nrm(ks[22], (N_MOE, N_EXPERTS, D_MODEL, 2 * D_FF_E), D_MODEL ** -0.5),
        "exp_w2": nrm(ks[23], (N_MOE, N_EXPERTS, D_FF_E, D_MODEL), BETA * D_FF_E ** -0.5),
    }


def reference(x, rel_bias, w_in, w_gate, b_gate, conv_w, conv_b, w_qk_m, w_v_m, w_if, b_if, m_norm_g,
              w_br_a, w_br_m, w_o, ln_g, ln_b, ffn_w13, ffn_w2, router_w, router_b, exp_w13, exp_w2):
    for l in range(DEPTH):
        y = token_mixer(x, rel_bias, w_in[l], w_gate[l], b_gate[l], conv_w[l], conv_b[l], w_qk_m[l],
                        w_v_m[l], w_if[l], b_if[l], m_norm_g[l], w_br_a[l], w_br_m[l], w_o[l])
        x = layer_norm(ALPHA * x + y, ln_g[l, 0], ln_b[l, 0])
        j = l // 2
        if l % 2 == 0:
            y = swiglu(x, ffn_w13[j], ffn_w2[j])
        else:
            y = moe_ffn(x, router_w[j], router_b[j], exp_w13[j], exp_w2[j])
        x = layer_norm(ALPHA * x + y, ln_g[l, 1], ln_b[l, 1])
    return x
```

```cpp
#include <hip/hip_runtime.h>
#include <cstdio>
#include <cstdint>

namespace pg8 {
#define PG8_LAS __attribute__((address_space(3)))
typedef unsigned short bf16_t;
typedef short bf16x8 __attribute__((ext_vector_type(8)));
typedef float f32x4 __attribute__((ext_vector_type(4)));
typedef float f32x2 __attribute__((ext_vector_type(2)));
typedef unsigned u32x4 __attribute__((ext_vector_type(4)));
constexpr int BM = 256, BK = 64, HALF = 128, HTB = HALF * BK * 2  , STAGE_BYTES = 8 * HTB, NXCD = 8, WGM = 8;

__host__ __device__ __forceinline__ int lds_byte(int r, int c) { const int st = (r >> 4) * 2 + (c >> 5), rr = r & 15, cc = c & 31, ob = rr * 64 + cc * 2; return st * 1024 + (ob ^ (((ob >> 9) & 1) << 5)); }
__host__ __device__ __forceinline__ void stage_rc(int b, int& R, int& C) { const int st = b / 1024, sb = b % 1024, swz = sb ^ (((sb >> 9) & 1) << 5); R = (st >> 1) * 16 + swz / 64; C = (st & 1) * 32 + (swz % 64) / 2; }
__host__ __device__ __forceinline__ int perm32(int rho) { const int n = rho >> 4, i = rho & 15; return 8 * (i >> 2) + 4 * n + (i & 3); }

struct Unit { int pm, pn; const char* a; const char* b; int x0, x1; };
struct Gemm { int lda, ldb, K; };

__host__ __device__ __forceinline__ void tile_of(int wgid, int nM, int nN, int& pm, int& pn) {
    const int nwg = nM * nN;
    { const int q = nwg / NXCD, r = nwg % NXCD, xcd = wgid % NXCD, off = wgid / NXCD; wgid = (xcd < r ? xcd * (q + 1) : r * (q + 1) + (xcd - r) * q) + off; }
    const int nig = WGM * nN, gid = wgid / nig, fm = gid * WGM, gsz = (nM - fm) < WGM ? (nM - fm) : WGM;
    pm = fm + ((wgid % nig) % gsz); pn = (wgid % nig) / gsz;
}

__device__ __forceinline__ unsigned cvt_pk_bf16(float lo, float hi) { unsigned r; asm volatile("v_cvt_pk_bf16_f32 %0, %1, %2" : "=v"(r) : "v"(lo), "v"(hi)); return r; }
__device__ __forceinline__ float bf_lo(unsigned w) { return __uint_as_float(w << 16); }
__device__ __forceinline__ float bf_hi(unsigned w) { return __uint_as_float(w & 0xffff0000u); }
__device__ __forceinline__ float sigmoidf_(float v) { return __builtin_amdgcn_rcpf(1.0f + __builtin_amdgcn_exp2f(-1.4426950408889634f * v)); }


struct EpiProj {
    static constexpr bool PERM = true, AFTER_DRAIN = false;
    bf16_t* proj; bf16_t* gate; const float* bgate; float qscale;
    __device__ __forceinline__ void operator()(const f32x4 (&acc)[2][2][4][2], const Unit& u, int wr, int wc, int fr, int fq) const {
        const int row0 = u.pm * BM + wr * 64 + fr;
        const bool isg = u.pn >= 10; const bool sig = u.pn >= 8; const float sc = u.pn < 2 ? qscale : 1.0f;
        bf16_t* base = isg ? gate : proj; const int ldc = isg ? 2048 : 3072  ; const int colt = isg ? (u.pn - 10) * BM : u.pn * BM;
        const int col0 = colt + wc * 32 + 8 * fq;
        f32x4 bv[2][2];
#pragma unroll
        for (int bj = 0; bj < 2; ++bj)
#pragma unroll
            for (int n = 0; n < 2; ++n) bv[bj][n] = isg ? *(const f32x4*)(bgate + col0 + bj * HALF + 4 * n) : (f32x4){0.f, 0.f, 0.f, 0.f};
#pragma unroll
        for (int ai = 0; ai < 2; ++ai)
#pragma unroll
            for (int m = 0; m < 4; ++m) { bf16_t* rowp = base + (size_t)(row0 + ai * HALF + m * 16) * ldc + col0;
#pragma unroll
                for (int bj = 0; bj < 2; ++bj) { f32x4 v0 = acc[ai][bj][m][0] + bv[bj][0], v1 = acc[ai][bj][m][1] + bv[bj][1];
                    if (sig) {
#pragma unroll
                        for (int e = 0; e < 4; ++e) { v0[e] = sigmoidf_(v0[e]); v1[e] = sigmoidf_(v1[e]); } }
                    v0 = v0 * sc; v1 = v1 * sc; u32x4 w; w.x = cvt_pk_bf16(v0[0], v0[1]); w.y = cvt_pk_bf16(v0[2], v0[3]); w.z = cvt_pk_bf16(v1[0], v1[1]); w.w = cvt_pk_bf16(v1[2], v1[3]);
                    *(u32x4*)(rowp + bj * HALF) = w; } }
    }
};
struct EpiBf16Sel {
    static constexpr bool PERM = true, AFTER_DRAIN = false;
    bf16_t* O; size_t tstride; int ldc;
    __device__ __forceinline__ void operator()(const f32x4 (&acc)[2][2][4][2], const Unit& u, int wr, int wc, int fr, int fq) const {
        const int row0 = u.pm * BM + wr * 64 + fr; bf16_t* base = O + (size_t)u.x0 * tstride; const int col0 = u.x1 + wc * 32 + 8 * fq;
#pragma unroll
        for (int ai = 0; ai < 2; ++ai)
#pragma unroll
            for (int m = 0; m < 4; ++m) { bf16_t* rowp = base + (size_t)(row0 + ai * HALF + m * 16) * ldc + col0;
#pragma unroll
                for (int bj = 0; bj < 2; ++bj) { const f32x4 v0 = acc[ai][bj][m][0], v1 = acc[ai][bj][m][1];
                    u32x4 w; w.x = cvt_pk_bf16(v0[0], v0[1]); w.y = cvt_pk_bf16(v0[2], v0[3]); w.z = cvt_pk_bf16(v1[0], v1[1]); w.w = cvt_pk_bf16(v1[2], v1[3]);
                    *(u32x4*)(rowp + bj * HALF) = w; } }
    }
};
struct EpiMerge {
    static constexpr bool PERM = true, AFTER_DRAIN = false;
    bf16_t* merged; const bf16_t* gate;
    __device__ __forceinline__ void operator()(const f32x4 (&acc)[2][2][4][2], const Unit& u, int wr, int wc, int fr, int fq) const {
        const int row0 = u.pm * BM + wr * 64 + fr; const int col0 = u.pn * BM + wc * 32 + 8 * fq; const int br = u.x0;
#pragma unroll
        for (int ai = 0; ai < 2; ++ai)
#pragma unroll
            for (int m = 0; m < 4; ++m) { const size_t row = (size_t)(row0 + ai * HALF + m * 16);
#pragma unroll
                for (int bj = 0; bj < 2; ++bj) { const f32x4 a0 = acc[ai][bj][m][0], a1 = acc[ai][bj][m][1];
                    const u32x4 g = *(const u32x4*)(gate + row * 2048 + br * 1024 + col0 + bj * HALF);
                    bf16_t* op = merged + row * 1024 + col0 + bj * HALF;
                    u32x4 p = (u32x4){0u, 0u, 0u, 0u}; if (br) p = *(const u32x4*)op;
                    float o[8];
                    o[0] = bf_lo(p.x) + bf_lo(g.x) * a0[0]; o[1] = bf_hi(p.x) + bf_hi(g.x) * a0[1]; o[2] = bf_lo(p.y) + bf_lo(g.y) * a0[2]; o[3] = bf_hi(p.y) + bf_hi(g.y) * a0[3];
                    o[4] = bf_lo(p.z) + bf_lo(g.z) * a1[0]; o[5] = bf_hi(p.z) + bf_hi(g.z) * a1[1]; o[6] = bf_lo(p.w) + bf_lo(g.w) * a1[2]; o[7] = bf_hi(p.w) + bf_hi(g.w) * a1[3];
                    u32x4 w; w.x = cvt_pk_bf16(o[0], o[1]); w.y = cvt_pk_bf16(o[2], o[3]); w.z = cvt_pk_bf16(o[4], o[5]); w.w = cvt_pk_bf16(o[6], o[7]);
                    *(u32x4*)op = w; } }
    }
};
struct EpiSwiglu {
    static constexpr bool PERM = true, AFTER_DRAIN = false;
    bf16_t* H; int ldc;
    __device__ __forceinline__ void operator()(const f32x4 (&acc)[2][2][4][2], const Unit& u, int wr, int wc, int fr, int fq) const {
        const int row0 = u.pm * BM + wr * 64 + fr; const int col0 = u.pn * HALF + wc * 32 + 8 * fq;
#pragma unroll
        for (int ai = 0; ai < 2; ++ai)
#pragma unroll
            for (int m = 0; m < 4; ++m) { bf16_t* rowp = H + (size_t)(row0 + ai * HALF + m * 16) * ldc + col0;
                float o[8];
#pragma unroll
                for (int n = 0; n < 2; ++n)
#pragma unroll
                    for (int e = 0; e < 4; ++e) { const float a = acc[ai][0][m][n][e], g = acc[ai][1][m][n][e]; o[4 * n + e] = a * sigmoidf_(a) * g; }
                u32x4 w; w.x = cvt_pk_bf16(o[0], o[1]); w.y = cvt_pk_bf16(o[2], o[3]); w.z = cvt_pk_bf16(o[4], o[5]); w.w = cvt_pk_bf16(o[6], o[7]);
                *(u32x4*)rowp = w; }
    }
};
struct EpiF32 {
    static constexpr bool PERM = false, AFTER_DRAIN = false;
    float* C; int ldc;
    __device__ __forceinline__ void operator()(const f32x4 (&acc)[2][2][4][2], const Unit& u, int wr, int wc, int fr, int fq) const {
        const int row0 = u.pm * BM + wr * 64 + fr, col0 = u.pn * BM + wc * 32 + 4 * fq;
#pragma unroll
        for (int ai = 0; ai < 2; ++ai)
#pragma unroll
            for (int m = 0; m < 4; ++m) { float* rowp = C + (size_t)(row0 + ai * HALF + m * 16) * ldc + col0;
#pragma unroll
                for (int bj = 0; bj < 2; ++bj)
#pragma unroll
                    for (int n = 0; n < 2; ++n) *(f32x4*)(rowp + bj * HALF + n * 16) = acc[ai][bj][m][n]; }
    }
};
struct EpiScatter {
    static constexpr bool PERM = false, AFTER_DRAIN = false;
    float* YE; const int* rowtok; const float* roww; int Mtok;
    __device__ __forceinline__ void operator()(const f32x4 (&acc)[2][2][4][2], const Unit& u, int wr, int wc, int fr, int fq) const {
        const int row0 = u.pm * BM + wr * 64 + fr, col0 = u.pn * BM + wc * 32 + 4 * fq;
#pragma unroll
        for (int ai = 0; ai < 2; ++ai)
#pragma unroll
            for (int m = 0; m < 4; ++m) { const int rho = row0 + ai * HALF + m * 16; const int tk = rowtok[rho]; const float w = roww[rho];
                if (tk >= 0) { float* rowp = YE + ((size_t)(tk >> 16) * Mtok + (size_t)(tk & 0xffff)) * 1024 + col0;
#pragma unroll
                    for (int bj = 0; bj < 2; ++bj)
#pragma unroll
                        for (int n = 0; n < 2; ++n) *(f32x4*)(rowp + bj * HALF + n * 16) = acc[ai][bj][m][n] * w; } }
    }
};

template <class Epi, class Sched, bool ALIGN_EPI = false, bool SP2 = false>
__device__ __forceinline__ void gemm_phase(PG8_LAS unsigned char* lds, const Gemm g, const Sched& S, const Epi& E) {
    const int tid = threadIdx.x, wid = __builtin_amdgcn_readfirstlane(tid >> 6), lane = tid & 63, wr = wid >> 2, wc = wid & 3, fr = lane & 15, fq = lane >> 4;
    const int K = g.K, nt = K / BK;
    unsigned voffA[2], voffB[2];
#pragma unroll
    for (int i = 0; i < 2; ++i) { int R, C; stage_rc(tid * 16 + i * 8192, R, C); const int Rb = Epi::PERM ? ((R & ~31) + perm32(R & 31)) : R;
        voffA[i] = (unsigned)(R * g.lda + C) * 2u; voffB[i] = (unsigned)(Rb * g.ldb + C) * 2u; }
    const size_t kstep = (size_t)(BK * 2);
    const size_t hstepA = (size_t)HALF * g.lda * 2, hstepB = (size_t)HALF * g.ldb * 2;
    const unsigned ldsw = (unsigned)wid * 1024u;
    const int aoff = lds_byte(wr * 64 + fr, fq * 8), boff = lds_byte(wc * 32 + fr, fq * 8);
#define PG8_SA(b, h) (((b) * 2 + (h)) * HTB)
#define PG8_SB(b, h) ((4 + (b) * 2 + (h)) * HTB)
#define PG8_STAGE(bufoff, gbase, voff) do { _Pragma("unroll") for (int _i = 0; _i < 2; ++_i) \
        __builtin_amdgcn_global_load_lds((const unsigned*)((const char*)(gbase) + (voff)[_i]), (PG8_LAS unsigned*)(lds + (bufoff) + ldsw + _i * 8192), 16, 0, 0); } while (0)
#define PG8_LDA(dst, b, h) do { _Pragma("unroll") for (int m = 0; m < 4; ++m) _Pragma("unroll") for (int k = 0; k < 2; ++k) dst[m][k] = *(const PG8_LAS bf16x8*)(lds + PG8_SA(b, h) + aoff + m * 2048 + k * 1024); } while (0)
#define PG8_LDB(dst, b, h) do { _Pragma("unroll") for (int n = 0; n < 2; ++n) _Pragma("unroll") for (int k = 0; k < 2; ++k) dst[n][k] = *(const PG8_LAS bf16x8*)(lds + PG8_SB(b, h) + boff + n * 2048 + k * 1024); } while (0)
#define PG8_MMA(ai, bj, At, Bt) do { __builtin_amdgcn_s_setprio(1); _Pragma("unroll") for (int m = 0; m < 4; ++m) _Pragma("unroll") for (int n = 0; n < 2; ++n) _Pragma("unroll") for (int k = 0; k < 2; ++k) \
        acc[ai][bj][m][n] = __builtin_amdgcn_mfma_f32_16x16x32_bf16(Bt[n][k], At[m][k], acc[ai][bj][m][n], 0, 0, 0); __builtin_amdgcn_s_setprio(0); } while (0)
#define PG8_WAIT_V(n) asm volatile("s_waitcnt vmcnt(" #n ")" ::: "memory")
#define PG8_WAIT_L(n) asm volatile("s_waitcnt lgkmcnt(" #n ")" ::: "memory")
#define PG8_BAR __builtin_amdgcn_s_barrier()
#define PG8_SCHED __builtin_amdgcn_sched_barrier(0)
    Unit cur, nxt; int ui = 0;
    if (!S.next(0, cur)) return;
    f32x4 acc[2][2][4][2];
#pragma unroll
    for (int a = 0; a < 2; ++a)
#pragma unroll
        for (int b = 0; b < 2; ++b)
#pragma unroll
            for (int m = 0; m < 4; ++m)
#pragma unroll
                for (int n = 0; n < 2; ++n) acc[a][b][m][n] = (f32x4){0.f, 0.f, 0.f, 0.f};
    bf16x8 At[4][2], B0[2][2], B1[2][2];
    const char* cA = cur.a; const char* cB = cur.b;
    S.a_ready(cur);
    if constexpr (SP2) {
        PG8_STAGE(PG8_SB(0, 0), cB, voffB); PG8_STAGE(PG8_SB(0, 1), cB + hstepB, voffB); PG8_STAGE(PG8_SA(0, 0), cA, voffA); PG8_STAGE(PG8_SA(0, 1), cA + hstepA, voffA);
        if (wr == 1) PG8_BAR;
        PG8_WAIT_V(2); PG8_BAR;
        PG8_STAGE(PG8_SB(1, 0), cB + kstep, voffB); PG8_STAGE(PG8_SA(1, 0), cA + kstep, voffA); PG8_STAGE(PG8_SB(1, 1), cB + hstepB + kstep, voffB);
        PG8_WAIT_V(6); PG8_BAR;
    } else {
        PG8_STAGE(PG8_SB(0, 0), cB, voffB); PG8_STAGE(PG8_SA(0, 0), cA, voffA); PG8_STAGE(PG8_SB(0, 1), cB + hstepB, voffB); PG8_STAGE(PG8_SA(0, 1), cA + hstepA, voffA);
        if (wr == 1) PG8_BAR;
        PG8_WAIT_V(4); PG8_BAR;
        PG8_STAGE(PG8_SB(1, 0), cB + kstep, voffB); PG8_STAGE(PG8_SA(1, 0), cA + kstep, voffA); PG8_STAGE(PG8_SB(1, 1), cB + hstepB + kstep, voffB);
        PG8_WAIT_V(6); PG8_BAR;
    }
    for (;;) {
        const bool has_next = S.next(ui + 1, nxt);
        const char* nA = has_next ? nxt.a : cA; const char* nB = has_next ? nxt.b : cB;
        for (int t = 0; t < nt; t += 2) {
            const bool last = (t == nt - 2);
            const char* a1 = cA + (size_t)(t + 1) * kstep;
            const char* a2 = last ? nA : cA + (size_t)(t + 2) * kstep; const char* b2 = last ? nB : cB + (size_t)(t + 2) * kstep;
            const char* a3 = a2 + kstep; const char* b3 = b2 + kstep;
            if (last && has_next) S.a_ready(nxt);
            if constexpr (SP2) {
            PG8_LDB(B0, 0, 0); PG8_LDB(B1, 0, 1); PG8_SCHED; PG8_LDA(At, 0, 0); PG8_STAGE(PG8_SA(1, 1), a1 + hstepA, voffA);
            PG8_WAIT_V(8); PG8_WAIT_L(0); PG8_BAR; PG8_MMA(0, 0, At, B0); PG8_MMA(0, 1, At, B1); PG8_BAR; PG8_SCHED;
            PG8_LDA(At, 0, 1); PG8_STAGE(PG8_SB(0, 0), b2, voffB); PG8_STAGE(PG8_SB(0, 1), b2 + hstepB, voffB); PG8_STAGE(PG8_SA(0, 0), a2, voffA);
            PG8_WAIT_V(8); PG8_WAIT_L(0); PG8_BAR; PG8_MMA(1, 0, At, B0); PG8_MMA(1, 1, At, B1); PG8_BAR; PG8_SCHED;
            PG8_LDB(B0, 1, 0); PG8_LDB(B1, 1, 1); PG8_SCHED; PG8_LDA(At, 1, 0); PG8_STAGE(PG8_SA(0, 1), a2 + hstepA, voffA);
            PG8_WAIT_V(8); PG8_WAIT_L(0); PG8_BAR; PG8_MMA(0, 0, At, B0); PG8_MMA(0, 1, At, B1); PG8_BAR; PG8_SCHED;
            PG8_LDA(At, 1, 1); PG8_STAGE(PG8_SB(1, 0), b3, voffB); PG8_STAGE(PG8_SB(1, 1), b3 + hstepB, voffB); PG8_STAGE(PG8_SA(1, 0), a3, voffA);
            PG8_WAIT_V(8); PG8_WAIT_L(0); PG8_BAR; PG8_MMA(1, 0, At, B0); PG8_MMA(1, 1, At, B1); PG8_BAR; PG8_SCHED;
            } else {
            PG8_LDB(B0, 0, 0); PG8_SCHED; PG8_LDA(At, 0, 0); PG8_STAGE(PG8_SA(1, 1), a1 + hstepA, voffA);
            PG8_WAIT_L(8); PG8_BAR; PG8_WAIT_L(0); PG8_MMA(0, 0, At, B0); PG8_BAR; PG8_SCHED;
            PG8_LDB(B1, 0, 1); PG8_STAGE(PG8_SB(0, 0), b2, voffB);
            PG8_BAR; PG8_WAIT_L(0); PG8_MMA(0, 1, At, B1); PG8_BAR;
            PG8_LDA(At, 0, 1); PG8_STAGE(PG8_SA(0, 0), a2, voffA);
            PG8_BAR; PG8_WAIT_L(0); PG8_MMA(1, 0, At, B0); PG8_BAR; PG8_SCHED;
            PG8_STAGE(PG8_SB(0, 1), b2 + hstepB, voffB);
            PG8_WAIT_V(6); PG8_BAR; PG8_MMA(1, 1, At, B1); PG8_BAR;
            PG8_LDB(B0, 1, 0); PG8_SCHED; PG8_LDA(At, 1, 0); PG8_STAGE(PG8_SA(0, 1), a2 + hstepA, voffA);
            PG8_WAIT_L(8); PG8_BAR; PG8_WAIT_L(0); PG8_MMA(0, 0, At, B0); PG8_BAR; PG8_SCHED;
            PG8_LDB(B1, 1, 1); PG8_STAGE(PG8_SB(1, 0), b3, voffB);
            PG8_BAR; PG8_WAIT_L(0); PG8_MMA(0, 1, At, B1); PG8_BAR;
            PG8_LDA(At, 1, 1); PG8_STAGE(PG8_SA(1, 0), a3, voffA);
            PG8_BAR; PG8_WAIT_L(0); PG8_MMA(1, 0, At, B0); PG8_BAR; PG8_SCHED;
            PG8_STAGE(PG8_SB(1, 1), b3 + hstepB, voffB);
            PG8_WAIT_V(6); PG8_BAR; PG8_MMA(1, 1, At, B1); PG8_BAR;
            }
        }
        if constexpr (ALIGN_EPI) { if (wr == 0) PG8_BAR; }
        if constexpr (!Epi::AFTER_DRAIN) { E(acc, cur, wr, wc, fr, fq); S.done(cur); }
        if (!has_next) break;
#pragma unroll
        for (int a = 0; a < 2; ++a)
#pragma unroll
            for (int b = 0; b < 2; ++b)
#pragma unroll
                for (int m = 0; m < 4; ++m)
#pragma unroll
                    for (int n = 0; n < 2; ++n) acc[a][b][m][n] = (f32x4){0.f, 0.f, 0.f, 0.f};
        cur = nxt; cA = nA; cB = nB; ++ui;
        if constexpr (ALIGN_EPI) { if (wr == 1) PG8_BAR; }
    }
    PG8_WAIT_V(0);
    if constexpr (!ALIGN_EPI) { if (wr == 0) PG8_BAR; }
    PG8_BAR;
    if constexpr (Epi::AFTER_DRAIN) { E.fused(acc, cur, wr, wc, fr, fq, lds, wid, lane); S.done(cur); }
#undef PG8_SA
#undef PG8_SB
#undef PG8_STAGE
#undef PG8_LDA
#undef PG8_LDB
#undef PG8_MMA
#undef PG8_WAIT_V
#undef PG8_WAIT_L
#undef PG8_BAR
#undef PG8_SCHED
}
}
#define GAS __attribute__((address_space(1)))
#define LAS __attribute__((address_space(3)))
typedef unsigned short bf16;
typedef unsigned v4u __attribute__((ext_vector_type(4)));
typedef float f32x4 __attribute__((ext_vector_type(4)));
typedef short bf16x8 __attribute__((ext_vector_type(8)));
typedef GAS unsigned gu32;
typedef GAS unsigned long long gu64;
#define RLX_AGENT __ATOMIC_RELAXED, __HIP_MEMORY_SCOPE_AGENT
#define LDS_WAIT() asm volatile("s_waitcnt lgkmcnt(0)" ::: "memory")
#define VM_WAIT() asm volatile("s_waitcnt vmcnt(0)" ::: "memory")
__device__ __forceinline__ unsigned long long rt() { return __builtin_amdgcn_s_memrealtime(); }
__device__ __forceinline__ unsigned f2bf(float f) { unsigned u = __builtin_bit_cast(unsigned, f); return (u + 0x7fffu + ((u >> 16) & 1u)) >> 16; }
__device__ __forceinline__ unsigned pk2(float lo, float hi) { return f2bf(lo) | (f2bf(hi) << 16); }
#define XB_TMO      128
#define XB_XCNT(j)  (256  + 64 * (j))
#define XB_XSUB(j)  (1280 + 64 * (j))
#define XB_XGEN(j)  (2304 + 64 * (j))
#define XB_TOP      3328
#define XB_TOPGEN   3392
#define XCD_BAR_WORDS 3456
#define XB_SPIN_CAP (1u << 18)

__device__ __forceinline__ unsigned xb_ld(unsigned* p)              { return __hip_atomic_load(p, __ATOMIC_RELAXED, __HIP_MEMORY_SCOPE_AGENT); }
__device__ __forceinline__ unsigned xb_add(unsigned* p, unsigned v) { return __hip_atomic_fetch_add(p, v, __ATOMIC_RELAXED, __HIP_MEMORY_SCOPE_AGENT); }
__device__ __forceinline__ unsigned xb_xcc_id() { return (unsigned)__builtin_amdgcn_s_getreg((3 << 11) | 20) & 0xFu; }
#define XB_SPIN(cond, bar) do { unsigned _sp = 0; while (cond) { __builtin_amdgcn_s_sleep(1); \
    if ((++_sp & 255u) == 0u) { if (xb_ld(&(bar)[XB_TMO])) break; if (_sp > XB_SPIN_CAP) { atomicAdd(&(bar)[XB_TMO], 1u); break; } } } } while (0)

struct XcdBarrier {
    unsigned* bar; unsigned x;
    volatile LAS unsigned* st;
};

__device__ __forceinline__ XcdBarrier xcd_barrier_post(unsigned* bar, volatile LAS unsigned* st) {
    XcdBarrier b; b.bar = bar; b.x = xb_xcc_id(); b.st = st;
    if (threadIdx.x == 0) (void)xb_add(&bar[XB_XCNT(b.x)], 1u);
    return b;
}
__device__ __forceinline__ void xcd_barrier_complete(unsigned* bar, unsigned x, unsigned& nloc, unsigned& nx) {
    const unsigned G = gridDim.x * gridDim.y * gridDim.z;
    unsigned sum, cnt, mine, sp = 0u;
    for (;;) {
        sum = 0u; cnt = 0u; mine = 0u;
#pragma unroll
        for (unsigned j = 0; j < 16; ++j) { const unsigned c = xb_ld(&bar[XB_XCNT(j)]); sum += c; cnt += (c > 0u) ? 1u : 0u; mine = (j == x) ? c : mine; }
        if (sum == G) break;
        __builtin_amdgcn_s_sleep(1);
        if ((++sp & 255u) == 0u) { if (xb_ld(&bar[XB_TMO])) break; if (sp > XB_SPIN_CAP) { atomicAdd(&bar[XB_TMO], 1u); break; } }
    }
    nloc = mine > 0u ? mine : 1u; nx = cnt > 0u ? cnt : 1u;
}

__device__ __forceinline__ void xcd_barrier(const XcdBarrier& b) {
    asm volatile("s_waitcnt vmcnt(0)" ::: "memory");
    __syncthreads();
    if (threadIdx.x == 0) {
        unsigned* bar = b.bar;
        __builtin_amdgcn_s_waitcnt(0);
        unsigned nloc = b.st[0], nx = b.st[1];
        if (nloc == 0u) { xcd_barrier_complete(bar, b.x, nloc, nx); b.st[0] = nloc; b.st[1] = nx; }
        const unsigned old = xb_add(&bar[XB_XSUB(b.x)], 1u);
        const unsigned gen = old / nloc;
        if (old + 1u == (gen + 1u) * nloc) {
            __builtin_amdgcn_fence(__ATOMIC_RELEASE, "agent");
            asm volatile("s_waitcnt vmcnt(0)" ::: "memory");
            const unsigned og = xb_add(&bar[XB_TOP], 1u);
            const unsigned tg = og / nx;
            if (og + 1u == (tg + 1u) * nx) xb_add(&bar[XB_TOPGEN], 1u);
            else XB_SPIN(xb_ld(&bar[XB_TOPGEN]) == tg, bar);
            __builtin_amdgcn_fence(__ATOMIC_ACQUIRE, "agent");
            xb_add(&bar[XB_XGEN(b.x)], 1u);
            asm volatile("s_waitcnt vmcnt(0)" ::: "memory");
        } else {
            XB_SPIN(xb_ld(&bar[XB_XGEN(b.x)]) == gen, bar);
            __builtin_amdgcn_fence(__ATOMIC_ACQUIRE, "agent");
            asm volatile("s_waitcnt vmcnt(0)" ::: "memory");
        }
    }
    __syncthreads();
}

constexpr int NWAVES = 8;
constexpr int M = 16384, D = 1024, PIN = 2560, PP = 3072  , NGATE = 2048, N1 = PIN + NGATE;
constexpr int FF = 2816, FE = 3584, NE = 8, RMAX = 34816  ;
constexpr int NCHUNK = 128, SELEM = 129 * 128  ;
constexpr float LN_EPS = 1e-5f, ALPHA = 1.4142135623730951f, LOG2E = 1.4426950408889634f;
constexpr float QSCALE = 0.125f * LOG2E, KSCALE_M = 0.08838834764831845f;
constexpr int NPH_L0 = 13, NPH_L1 = 15, NPH = 1 + NPH_L0 + NPH_L1;
#ifndef MK_PER_PHASE
#define MK_PER_PHASE 0
#endif

constexpr size_t MiB = 1u << 20;
constexpr size_t WS_CTL = 0, CTL_ZERO_BYTES = 1 * MiB;
constexpr size_t WS_W1T = 2 * MiB, W1T_L = 9 * MiB;
constexpr size_t WS_WBR = 20 * MiB, WBR_L = 2 * MiB;
constexpr size_t WS_WOT = 24 * MiB, WOT_L = 2 * MiB;
constexpr size_t WS_WQKV = 28 * MiB, WQKV_L = 1 * MiB;
constexpr size_t WS_W13T = 30 * MiB;
constexpr size_t WS_W2T = 41 * MiB;
constexpr size_t WS_EW13T = 48 * MiB, EW13T_E = 14 * MiB;
constexpr size_t WS_EW2T = 160 * MiB, EW2T_E = 7 * MiB;
constexpr size_t WS_X1F = 216 * MiB, WS_X2F = 280 * MiB, WS_XB = 344 * MiB;
constexpr size_t WS_PROJ = 376 * MiB, WS_GATE = 472 * MiB, WS_QKVM = 536 * MiB, QKVM_T = 16 * MiB, WS_OP = 584 * MiB, WS_LSE = 632 * MiB, WS_Y = 634 * MiB;
constexpr size_t WS_DCT = 666 * MiB, WS_STATE = 699 * MiB, WS_SMALL = 716 * MiB, WS_MERGED = 718 * MiB, WS_YF = 750 * MiB;
constexpr size_t WS_H = 376 * MiB;
constexpr size_t WS_XG = 376 * MiB, WS_HH = 444 * MiB, WS_YE = 682 * MiB, WS_ROUTE = 814 * MiB, WS_END = 816 * MiB;
static_assert(WS_HH + (size_t)RMAX * FE * 2 <= WS_YE && WS_YE + (size_t)2 * M * D * 4 <= WS_ROUTE, "MoE overlay");
static_assert(WS_DCT + (size_t)512 * SELEM * 4 <= WS_STATE && WS_STATE + (size_t)512 * SELEM * 2 <= WS_SMALL, "mLSTM buffers");
constexpr int CW_TMO = 0, CW_CODE = 1, CW_BAR = 4096;

constexpr int RING_OFF = 0, RING_BYTES = 131072;
constexpr int LDSCTL_OFF = RING_BYTES, MISC_OFF = LDSCTL_OFF + 320;
constexpr int LDS_BYTES = 147456;
static_assert(MISC_OFF + 128 <= LDS_BYTES, "LDS map");

typedef unsigned v2u __attribute__((ext_vector_type(2)));
typedef float f32x16 __attribute__((ext_vector_type(16)));
typedef float f32x2_t __attribute__((ext_vector_type(2)));
typedef __bf16 bf16x2_t __attribute__((ext_vector_type(2)));
__device__ __forceinline__ unsigned cvtpk(float lo, float hi) { f32x2_t v = {lo, hi}; bf16x2_t b = __builtin_convertvector(v, bf16x2_t); return __builtin_bit_cast(unsigned, b); }
__device__ __forceinline__ float bflo(unsigned w) { return __uint_as_float(w << 16); }
__device__ __forceinline__ float bfhi(unsigned w) { return __uint_as_float(w & 0xffff0000u); }
__device__ __forceinline__ float bf2f(bf16 b) { return __uint_as_float((unsigned)b << 16); }
__device__ __forceinline__ float fexp2(float x) { return __builtin_amdgcn_exp2f(x); }
__device__ __forceinline__ float fexp(float x) { return __builtin_amdgcn_exp2f(x * LOG2E); }
__device__ __forceinline__ float wave_sum(float v) {
#pragma unroll
    for (int o = 1; o < 64; o <<= 1) v += __shfl_xor(v, o);
    return v;
}
__device__ __forceinline__ float wave_max(float v) {
#pragma unroll
    for (int o = 1; o < 64; o <<= 1) v = fmaxf(v, __shfl_xor(v, o));
    return v;
}

struct Frame {
    LAS unsigned char* lds;
    volatile LAS unsigned* MISC;
    gu32* ctl;
    int tid, lane, wave, vcu, G, bid;
};

__device__ __forceinline__ void tr_item(const float* W, int N, int k0, int n0, bf16* WT, int ldk, int drow0, int dcol0, LAS float* scr, int lane) {
#pragma unroll 8
    for (int i = 0; i < 32; ++i) { const int kk = 2 * i + (lane >> 5); scr[kk * 33 + (lane & 31)] = W[(size_t)(k0 + kk) * N + n0 + (lane & 31)]; }
    LDS_WAIT(); asm volatile("" ::: "memory");
    const int c = lane & 7;
#pragma unroll
    for (int j = 0; j < 4; ++j) { const int n = (lane >> 3) + 8 * j; const LAS float* s = scr + (8 * c) * 33 + n;
        v4u o; o.x = pk2(s[0 * 33], s[1 * 33]); o.y = pk2(s[2 * 33], s[3 * 33]); o.z = pk2(s[4 * 33], s[5 * 33]); o.w = pk2(s[6 * 33], s[7 * 33]);
        *(GAS v4u*)(WT + (size_t)(drow0 + n) * ldk + dcol0 + k0 + 8 * c) = o; }
    LDS_WAIT(); asm volatile("" ::: "memory");
}
__device__ __forceinline__ int w13_row(int n0, int F_) { return n0 < F_ ? 256 * (n0 / 128) + (n0 % 128) : 256 * ((n0 - F_) / 128) + 128 + ((n0 - F_) % 128); }

constexpr int I_WIN = 16 * 80, I_WG = 16 * 64, I_BR = 8 * 32, I_WO = 16 * 32, I_QKV = 96, I_Z = 12;
constexpr int L_ITEMS = I_WIN + I_WG + 2 * I_BR + I_WO + I_QKV + I_Z;
constexpr int I_W13 = 16 * 176, I_W2 = 44 * 32, I_E13 = 16 * 224, I_E2 = 56 * 32, I_EXP = I_E13 + I_E2;
constexpr int P0_ITEMS = 2 * L_ITEMS + I_W13 + I_W2 + NE * I_EXP;

__device__ __forceinline__ void p0_prologue(Frame& F, const float* const* in, unsigned char* ws) {
    LAS float* scr = (LAS float*)(F.lds + RING_OFF + F.wave * 16384);
    const int gw = F.vcu * NWAVES + F.wave, NGW = F.G * NWAVES, lane = F.lane;
    for (int it = gw; it < P0_ITEMS; it += NGW) {
        int r = it;
        if (r < 2 * L_ITEMS) {
            const int l = r / L_ITEMS; r -= l * L_ITEMS;
            bf16* w1t = (bf16*)(ws + WS_W1T + l * W1T_L); bf16* wbr = (bf16*)(ws + WS_WBR + l * WBR_L); bf16* wot = (bf16*)(ws + WS_WOT + l * WOT_L); bf16* wqkv = (bf16*)(ws + WS_WQKV + l * WQKV_L);
            if (r < I_WIN) { const int kb = r / 80, nb = r % 80; tr_item(in[2] + (size_t)l * D * PIN, PIN, 64 * kb, 32 * nb, w1t, D, 32 * nb, 0, scr, lane); continue; } r -= I_WIN;
            if (r < I_WG) { const int kb = r / 64, nb = r % 64; tr_item(in[3] + (size_t)l * D * NGATE, NGATE, 64 * kb, 32 * nb, w1t, D, PIN + 32 * nb, 0, scr, lane); continue; } r -= I_WG;
            if (r < I_BR) { const int kb = r / 32, nb = r % 32; tr_item(in[12] + (size_t)l * 512 * D, D, 64 * kb, 32 * nb, wbr, D, 32 * nb, 0, scr, lane); continue; } r -= I_BR;
            if (r < I_BR) { const int kb = r / 32, nb = r % 32; tr_item(in[13] + (size_t)l * 512 * D, D, 64 * kb, 32 * nb, wbr, D, 32 * nb, 512, scr, lane); continue; } r -= I_BR;
            if (r < I_WO) { const int kb = r / 32, nb = r % 32; tr_item(in[14] + (size_t)l * D * D, D, 64 * kb, 32 * nb, wot, D, 32 * nb, 0, scr, lane); continue; } r -= I_WO;
            if (r < I_QKV) { const int pn = r / 16, rr = r % 16, hh = rr / 8, q = rr % 8, kb = q / 4, nb = q % 4; const int head = 2 * (pn & 1) + hh;
                const float* src = pn < 4 ? in[7] + (size_t)(((l * 2 + (pn >> 1)) * 4 + head) * 16384) : in[8] + (size_t)((l * 4 + head) * 16384);
                tr_item(src, 128, 64 * kb, 32 * nb, wqkv + pn * 65536, 256, 128 * hh + 32 * nb, 128 * hh, scr, lane); continue; } r -= I_QKV;
            { const int pn = r / 2, hh = r % 2; bf16* base = wqkv + pn * 65536 + (128 * hh) * 256 + 128 * (1 - hh);
#pragma unroll 4
              for (int i = 0; i < 32; ++i) { const int idx = i * 64 + lane, row = idx >> 4, piece = idx & 15; *(GAS v4u*)(base + row * 256 + piece * 8) = (v4u){0u, 0u, 0u, 0u}; } }
            continue;
        }
        r -= 2 * L_ITEMS;
        if (r < I_W13) { const int kb = r / 176, nb = r % 176; tr_item(in[17], 2 * FF, 64 * kb, 32 * nb, (bf16*)(ws + WS_W13T), D, w13_row(32 * nb, FF), 0, scr, lane); continue; } r -= I_W13;
        if (r < I_W2) { const int kb = r / 32, nb = r % 32; tr_item(in[18], D, 64 * kb, 32 * nb, (bf16*)(ws + WS_W2T), FF, 32 * nb, 0, scr, lane); continue; } r -= I_W2;
        { const int e = r / I_EXP; int rr = r % I_EXP;
          if (rr < I_E13) { const int kb = rr / 224, nb = rr % 224; tr_item(in[21] + (size_t)e * D * 2 * FE, 2 * FE, 64 * kb, 32 * nb, (bf16*)(ws + WS_EW13T + e * EW13T_E), D, w13_row(32 * nb, FE), 0, scr, lane); }
          else { rr -= I_E13; const int kb = rr / 32, nb = rr % 32; tr_item(in[22] + (size_t)e * FE * D, D, 64 * kb, 32 * nb, (bf16*)(ws + WS_EW2T + e * EW2T_E), FE, 32 * nb, 0, scr, lane); } }
    }
    const float* x = in[0]; bf16* xb = (bf16*)(ws + WS_XB);
    for (int m = gw; m < M; m += NGW) {
        const GAS f32x4* xr = (const GAS f32x4*)(x + (size_t)m * D) + lane; GAS unsigned long long* o8 = (GAS unsigned long long*)(xb + (size_t)m * D) + lane;
#pragma unroll
        for (int j = 0; j < 4; ++j) { const f32x4 v = xr[64 * j]; o8[64 * j] = (unsigned long long)pk2(v.x, v.y) | ((unsigned long long)pk2(v.z, v.w) << 32); }
    }
}

struct SchedGrid {
    int nM, nN, G, c; const char* A; const char* B; size_t astep, bstep;
    __device__ __forceinline__ bool next(int i, pg8::Unit& u) const { const long L = (long)i * G + c; if (L >= (long)nM * nN) return false;
        pg8::tile_of((int)L, nM, nN, u.pm, u.pn); u.a = A + (size_t)u.pm * astep; u.b = B + (size_t)u.pn * bstep; u.x0 = 0; u.x1 = 0; return true; }
    __device__ __forceinline__ void a_ready(const pg8::Unit&) const {}
    __device__ __forceinline__ void done(const pg8::Unit&) const {}
};
struct SchedQkvM {
    int G, c; const char* proj; const char* wqkv;
    __device__ __forceinline__ bool next(int i, pg8::Unit& u) const { const long L = (long)i * G + c; if (L >= 64 * 6) return false;
        pg8::tile_of((int)L, 64, 6, u.pm, u.pn); const int pair = u.pn & 1;
        u.a = proj + (size_t)u.pm * 256 * PP * 2 + (size_t)((u.pn < 4 ? PIN : 1536) + 256 * pair) * 2; u.b = wqkv + (size_t)u.pn * 65536 * 2; u.x0 = u.pn >> 1; u.x1 = 256 * pair; return true; }
    __device__ __forceinline__ void a_ready(const pg8::Unit&) const {}
    __device__ __forceinline__ void done(const pg8::Unit&) const {}
};
struct SchedMerge {
    int G, c; const char* Y; const char* wbr;
    __device__ __forceinline__ bool next(int i, pg8::Unit& u) const { const long L = (long)(i >> 1) * G + c; if (L >= 64 * 4) return false; const int br = i & 1;
        pg8::tile_of((int)L, 64, 4, u.pm, u.pn); u.a = Y + (size_t)u.pm * 256 * D * 2 + br * 1024; u.b = wbr + (size_t)u.pn * 256 * D * 2 + br * 1024; u.x0 = br; u.x1 = 0; return true; }
    __device__ __forceinline__ void a_ready(const pg8::Unit&) const {}
    __device__ __forceinline__ void done(const pg8::Unit&) const {}
};
struct SchedMoe {
    int nN, G, c; int tseg[9]; const char* A; const char* B; size_t astep, bstep, estep;
    __device__ __forceinline__ bool next(int i, pg8::Unit& u) const { const int nM = tseg[8]; const long L = (long)i * G + c; if (L >= (long)nM * nN) return false;
        pg8::tile_of((int)L, nM, nN, u.pm, u.pn); int e = 0;
#pragma unroll
        for (int j = 1; j < 8; ++j) e += (u.pm >= tseg[j]) ? 1 : 0;
        u.a = A + (size_t)u.pm * astep; u.b = B + (size_t)e * estep + (size_t)u.pn * bstep; u.x0 = e; u.x1 = 0; return true; }
    __device__ __forceinline__ void a_ready(const pg8::Unit&) const {}
    __device__ __forceinline__ void done(const pg8::Unit&) const {}
};

__device__ __forceinline__ float bfel(const v4u& v, int i) { const unsigned w = (i >> 1) == 0 ? v.x : (i >> 1) == 1 ? v.y : (i >> 1) == 2 ? v.z : v.w; return (i & 1) ? bfhi(w) : bflo(w); }
__device__ __forceinline__ void conv_phase(Frame& F, bf16* proj, const float* cw  , const float* cb  ) {
    const int gw = F.vcu * NWAVES + F.wave, NGW = F.G * NWAVES, lane = F.lane;
    float w[4][8], b[8];
#pragma unroll
    for (int j = 0; j < 4; ++j)
#pragma unroll
        for (int i = 0; i < 8; ++i) w[j][i] = cw[j * 512 + 8 * lane + i];
#pragma unroll
    for (int i = 0; i < 8; ++i) b[i] = cb[8 * lane + i];
    for (int item = gw; item < M / 8; item += NGW) {
        const int t0 = item * 8;
        v4u r[11];
#pragma unroll
        for (int k = 0; k < 11; ++k) { const int t = t0 - 3 + k; r[k] = (v4u){0u, 0u, 0u, 0u}; if (t >= 0) r[k] = *(const GAS v4u*)(proj + (size_t)t * PP + 1536 + 8 * lane); }
#pragma unroll
        for (int tt = 0; tt < 8; ++tt) {
            float o[8];
#pragma unroll
            for (int i = 0; i < 8; ++i) { float a = b[i];
#pragma unroll
                for (int j = 0; j < 4; ++j) a += w[j][i] * bfel(r[tt + j], i);
                o[i] = a * __builtin_amdgcn_rcpf(1.0f + fexp(-a)); }
            v4u ov; ov.x = cvtpk(o[0], o[1]); ov.y = cvtpk(o[2], o[3]); ov.z = cvtpk(o[4], o[5]); ov.w = cvtpk(o[6], o[7]);
            *(GAS v4u*)(proj + (size_t)(t0 + tt) * PP + PIN + 8 * lane) = ov;
        }
    }
}

__device__ __forceinline__ void gates_phase(Frame& F, const bf16* qkvm  , const float* wif  , const float* bif  , float* IG, float* FG) {
    const int gw = F.vcu * NWAVES + F.wave, NGW = F.G * NWAVES, lane = F.lane;
    for (int item = gw; item < M / 8; item += NGW) {
        const int t0 = item * 8;
        float acc[8][8];
#pragma unroll
        for (int t = 0; t < 8; ++t)
#pragma unroll
            for (int c = 0; c < 8; ++c) acc[t][c] = 0.f;
#pragma unroll 1
        for (int seg = 0; seg < 3; ++seg) {
            float w[8][8];
#pragma unroll
            for (int i = 0; i < 8; ++i) { const GAS f32x4* wp = (const GAS f32x4*)(wif + (size_t)(seg * 512 + 8 * lane + i) * 8); const f32x4 w0 = wp[0], w1 = wp[1];
                w[i][0] = w0.x; w[i][1] = w0.y; w[i][2] = w0.z; w[i][3] = w0.w; w[i][4] = w1.x; w[i][5] = w1.y; w[i][6] = w1.z; w[i][7] = w1.w; }
            const bf16* src = qkvm + (size_t)seg * M * 512;
#pragma unroll
            for (int t = 0; t < 8; ++t) { const v4u v = *(const GAS v4u*)(src + (size_t)(t0 + t) * 512 + 8 * lane);
#pragma unroll
                for (int i = 0; i < 8; ++i) { const float xv = bfel(v, i);
#pragma unroll
                    for (int c = 0; c < 8; ++c) acc[t][c] += xv * w[i][c]; } }
        }
        float mine = 0.f;
#pragma unroll
        for (int t = 0; t < 8; ++t)
#pragma unroll
            for (int c = 0; c < 8; ++c) { const float s = wave_sum(acc[t][c]); if (lane == t * 8 + c) mine = s; }
        const int t = t0 + (lane >> 3), c = lane & 7;
        const float v = mine + bif[c];
        if (c < 4) IG[(size_t)t * 4 + c] = v;
        else FG[(size_t)t * 4 + (c - 4)] = fminf(v, 0.f) - __logf(1.0f + __expf(-fabsf(v)));
    }
}

__device__ __forceinline__ int rel_bucket(int dist) {
    if (dist < 16) return dist;
    float t = logf((float)dist / 16.0f); t = t / 4.852030263919617f; t = t * 16.0f;
    const int lb = 16 + (int)t; return lb < 31 ? lb : 31;
}
constexpr int VTP = 260;
constexpr int ATT_VT_BYTES = 2 * 64 * VTP * 2, ATT_TBP = 132;
#define MFMA32(a, b, c) __builtin_amdgcn_mfma_f32_32x32x16_bf16((a), (b), (c), 0, 0, 0)
#define MFMA16(a, b, c) __builtin_amdgcn_mfma_f32_16x16x32_bf16((a), (b), (c), 0, 0, 0)
__device__ __forceinline__ void attn_phase(Frame& F, const bf16* proj, bf16* OP  , float* LSE  , const float* rel_bias  ) {
    LAS bf16* VT = (LAS bf16*)(F.lds + RING_OFF);
    LAS float* TB = (LAS float*)(F.lds + RING_OFF + ATT_VT_BYTES);
    const int tid = F.tid, lane = F.lane, wave = F.wave;
    __syncthreads();
    for (int idx = tid; idx < 3 * 8 * 129; idx += NWAVES * 64) { const int p = idx / (8 * 129), rem = idx % (8 * 129), h = rem / 129, rel = rem % 129; const int dil = p == 0 ? 1 : (p == 1 ? 4 : 16);
        TB[(p * 8 + h) * ATT_TBP + rel] = rel_bias[rel_bucket(rel * dil) * 8 + h] * LOG2E; }
    const int qi = lane & 31, half = lane >> 5, hh = wave >> 2, qsub = wave & 3;
    for (int u = F.bid; u < 3 * 128 * 4; u += F.G) {
        const int p = u >> 9, rem = u & 511, hp = rem & 3, blk = rem >> 2;
        const int dil = p == 0 ? 1 : (p == 1 ? 4 : 16), nbpc = 128 / dil, cls = blk / nbpc, jb = blk % nbpc;
        __syncthreads();
        {
            const int hh2 = tid >> 8, uu = tid & 255, kl = uu & 31, piece = uu >> 5, hd = 2 * hp + hh2;
#pragma unroll
            for (int it = 0; it < 8; ++it) { const int key = kl + 32 * it, jp = 128 * jb - 128 + key;
                v4u v = (v4u){0u, 0u, 0u, 0u};
                if (jp >= 0) v = *(const GAS v4u*)(proj + (size_t)(cls + dil * jp) * PP + 1024 + hd * 64 + piece * 8);
                LAS bf16* dst = VT + (hh2 * 64 + piece * 8) * VTP + key;
                dst[0 * VTP] = (bf16)(v.x & 0xffffu); dst[1 * VTP] = (bf16)(v.x >> 16); dst[2 * VTP] = (bf16)(v.y & 0xffffu); dst[3 * VTP] = (bf16)(v.y >> 16);
                dst[4 * VTP] = (bf16)(v.z & 0xffffu); dst[5 * VTP] = (bf16)(v.z >> 16); dst[6 * VTP] = (bf16)(v.w & 0xffffu); dst[7 * VTP] = (bf16)(v.w >> 16); }
        }
        const int head = 2 * hp + hh, jq0 = 128 * jb + 32 * qsub;
        const size_t tokq = (size_t)(cls + dil * (jq0 + qi));
        bf16x8 qf[4];
#pragma unroll
        for (int s = 0; s < 4; ++s) qf[s] = *(const GAS bf16x8*)(proj + tokq * PP + head * 64 + 16 * s + 8 * half);
        f32x16 S[5];
#pragma unroll
        for (int kb = 0; kb < 5; ++kb) {
            const int jk = jq0 - 128 + 32 * kb + qi; const bool ok = jk >= 0; const size_t tokk = (size_t)(cls + dil * (ok ? jk : 0));
            bf16x8 kf[4];
#pragma unroll
            for (int s = 0; s < 4; ++s) { kf[s] = (bf16x8){0, 0, 0, 0, 0, 0, 0, 0}; if (ok) kf[s] = *(const GAS bf16x8*)(proj + tokk * PP + 512 + head * 64 + 16 * s + 8 * half); }
            f32x16 a;
#pragma unroll
            for (int i = 0; i < 16; ++i) a[i] = 0.f;
#pragma unroll
            for (int s = 0; s < 4; ++s) a = MFMA32(kf[s], qf[s], a);
            S[kb] = a;
        }
        const LAS float* tb = TB + (p * 8 + head) * ATT_TBP;
        float mx = -INFINITY;
#pragma unroll
        for (int kb = 0; kb < 5; ++kb)
#pragma unroll
            for (int i = 0; i < 16; ++i) { const int kr = (i & 3) + 8 * (i >> 2) + 4 * half; const int rel = qi + 128 - 32 * kb - kr; const int jk = jq0 - 128 + 32 * kb + kr;
                const int relc = rel < 0 ? 0 : (rel > 128 ? 128 : rel);
                const bool ok = (rel >= 0) && (rel <= 128) && (jk >= 0);
                const float v = ok ? S[kb][i] + tb[relc] : -INFINITY; S[kb][i] = v; mx = fmaxf(mx, v); }
        mx = fmaxf(mx, __shfl_xor(mx, 32));
        float sum = 0.f;
#pragma unroll
        for (int kb = 0; kb < 5; ++kb)
#pragma unroll
            for (int i = 0; i < 16; ++i) { const float pe = fexp2(S[kb][i] - mx); S[kb][i] = pe; sum += pe; }
        sum += __shfl_xor(sum, 32);
        __syncthreads();
        f32x16 O[2];
#pragma unroll
        for (int db = 0; db < 2; ++db)
#pragma unroll
            for (int i = 0; i < 16; ++i) O[db][i] = 0.f;
        const LAS bf16* vbase = VT + (hh * 64 + qi) * VTP + 32 * qsub + 4 * half;
#pragma unroll
        for (int kb = 0; kb < 5; ++kb)
#pragma unroll
            for (int s2 = 0; s2 < 2; ++s2) {
                v4u pw; pw.x = cvtpk(S[kb][8 * s2 + 0], S[kb][8 * s2 + 1]); pw.y = cvtpk(S[kb][8 * s2 + 2], S[kb][8 * s2 + 3]); pw.z = cvtpk(S[kb][8 * s2 + 4], S[kb][8 * s2 + 5]); pw.w = cvtpk(S[kb][8 * s2 + 6], S[kb][8 * s2 + 7]);
                const bf16x8 pf = __builtin_bit_cast(bf16x8, pw);
#pragma unroll
                for (int db = 0; db < 2; ++db) { const LAS bf16* vp = vbase + db * 32 * VTP + 32 * kb + 16 * s2;
                    const v2u lo = *(const LAS v2u*)vp, hi = *(const LAS v2u*)(vp + 8);
                    const v4u aw = (v4u){lo.x, lo.y, hi.x, hi.y};
                    O[db] = MFMA32(__builtin_bit_cast(bf16x8, aw), pf, O[db]); }
            }
        const float inv = 1.0f / sum;
        bf16* orow = OP + ((size_t)p * M + tokq) * 512 + head * 64;
#pragma unroll
        for (int db = 0; db < 2; ++db)
#pragma unroll
            for (int g4 = 0; g4 < 4; ++g4) { v2u w; w.x = cvtpk(O[db][4 * g4 + 0] * inv, O[db][4 * g4 + 1] * inv); w.y = cvtpk(O[db][4 * g4 + 2] * inv, O[db][4 * g4 + 3] * inv);
                *(GAS v2u*)(orow + 32 * db + 8 * g4 + 4 * half) = w; }
        if (half == 0) LSE[((size_t)p * M + tokq) * 8 + head] = mx + __log2f(sum);
    }
    __syncthreads();
}
__device__ __forceinline__ void combine_phase(Frame& F, const bf16* OP, const float* LSE, bf16* Y) {
    const int gw = F.vcu * NWAVES + F.wave, NGW = F.G * NWAVES, lane = F.lane, head = lane >> 3;
    for (int t = gw; t < M; t += NGW) {
        const float l0 = LSE[((size_t)0 * M + t) * 8 + head], l1 = LSE[((size_t)1 * M + t) * 8 + head], l2 = LSE[((size_t)2 * M + t) * 8 + head];
        const float mx = fmaxf(l0, fmaxf(l1, l2)); float w0 = fexp2(l0 - mx), w1 = fexp2(l1 - mx), w2 = fexp2(l2 - mx); const float inv = 1.0f / (w0 + w1 + w2); w0 *= inv; w1 *= inv; w2 *= inv;
        const v4u a = *(const GAS v4u*)(OP + ((size_t)0 * M + t) * 512 + 8 * lane), b = *(const GAS v4u*)(OP + ((size_t)1 * M + t) * 512 + 8 * lane), c = *(const GAS v4u*)(OP + ((size_t)2 * M + t) * 512 + 8 * lane);
        float o[8];
#pragma unroll
        for (int i = 0; i < 8; ++i) o[i] = w0 * bfel(a, i) + w1 * bfel(b, i) + w2 * bfel(c, i);
        v4u ov; ov.x = cvtpk(o[0], o[1]); ov.y = cvtpk(o[2], o[3]); ov.z = cvtpk(o[4], o[5]); ov.w = cvtpk(o[6], o[7]);
        *(GAS v4u*)(Y + (size_t)t * D + 8 * lane) = ov;
    }
}

constexpr int TP = 136;
constexpr int ML_VTX = 0, ML_KWT = 144 * TP * 2, ML_SC = ML_KWT + 128 * TP * 2;
constexpr int MO_KS = 0, MO_VTX = 128 * TP * 2, MO_CTX = MO_VTX + 144 * TP * 2, MO_SC = MO_CTX + 144 * TP * 2;
static_assert(MO_SC + 4096 <= RING_BYTES, "mLSTM LDS map");

__device__ __forceinline__ float scan128_add(float v, int tid, int lane, int wave, LAS float* sc) {
#pragma unroll
    for (int o = 1; o < 64; o <<= 1) { const float t = __shfl_up(v, o); if (lane >= o) v += t; }
    __syncthreads();
    if (tid == 63) sc[0] = v;
    __syncthreads();
    if (wave == 1) v += sc[0];
    return v;
}
__device__ __forceinline__ float scan128_max(float v, int tid, int lane, int wave, LAS float* sc) {
#pragma unroll
    for (int o = 1; o < 64; o <<= 1) { const float t = __shfl_up(v, o); if (lane >= o) v = fmaxf(v, t); }
    __syncthreads();
    if (tid == 63) sc[1] = v;
    __syncthreads();
    if (wave == 1) v = fmaxf(v, sc[1]);
    return v;
}
template <bool SCALE>
__device__ __forceinline__ void stage_T(const bf16* src  , int pitch, LAS bf16* dst, const LAS float* wv, int tid) {
    const int s_lo = tid & 31, piece = tid >> 5;
#pragma unroll
    for (int it = 0; it < 4; ++it) { const int s = s_lo + 32 * it; const v4u v = *(const GAS v4u*)(src + (size_t)s * pitch + piece * 8);
        LAS bf16* d = dst + (piece * 8) * TP + s;
        if (SCALE) { const float w = wv[s];
            const unsigned a = cvtpk(bflo(v.x) * w, bfhi(v.x) * w), b = cvtpk(bflo(v.y) * w, bfhi(v.y) * w), c = cvtpk(bflo(v.z) * w, bfhi(v.z) * w), e = cvtpk(bflo(v.w) * w, bfhi(v.w) * w);
            d[0 * TP] = (bf16)(a & 0xffffu); d[1 * TP] = (bf16)(a >> 16); d[2 * TP] = (bf16)(b & 0xffffu); d[3 * TP] = (bf16)(b >> 16);
            d[4 * TP] = (bf16)(c & 0xffffu); d[5 * TP] = (bf16)(c >> 16); d[6 * TP] = (bf16)(e & 0xffffu); d[7 * TP] = (bf16)(e >> 16);
        } else {
            d[0 * TP] = (bf16)(v.x & 0xffffu); d[1 * TP] = (bf16)(v.x >> 16); d[2 * TP] = (bf16)(v.y & 0xffffu); d[3 * TP] = (bf16)(v.y >> 16);
            d[4 * TP] = (bf16)(v.z & 0xffffu); d[5 * TP] = (bf16)(v.z >> 16); d[6 * TP] = (bf16)(v.w & 0xffffu); d[7 * TP] = (bf16)(v.w >> 16); }
    }
}
__device__ __forceinline__ void fill_ext_rows(LAS bf16* tile, bf16 fill, int tid) {
    for (int idx = tid; idx < 16 * 128; idx += NWAVES * 64) { const int r = idx >> 7, c = idx & 127; tile[(128 + r) * TP + c] = r == 0 ? fill : (bf16)0; }
}

__device__ __forceinline__ void mlocal_phase(Frame& F, const bf16* qkvm, const float* IG, const float* FG, float* DCT, float* BL, float* GMAX) {
    LAS bf16* VTX = (LAS bf16*)(F.lds + RING_OFF + ML_VTX); LAS bf16* KWT = (LAS bf16*)(F.lds + RING_OFF + ML_KWT);
    LAS float* sc = (LAS float*)(F.lds + RING_OFF + ML_SC); LAS float* wv = sc + 16;
    const int tid = F.tid, lane = F.lane, wave = F.wave;
    const bf16* KM = qkvm + (size_t)M * 512; const bf16* VM = qkvm + (size_t)2 * M * 512;
    for (int u = F.bid; u < NCHUNK * 4; u += F.G) {
        const int c = u >> 2, h = u & 3, t0 = 128 * c;
        __syncthreads();
        float fv = 0.f, iv = 0.f;
        if (tid < 128) { fv = FG[(size_t)(t0 + tid) * 4 + h]; iv = IG[(size_t)(t0 + tid) * 4 + h]; }
        const float b = scan128_add(fv, tid, lane, wave, sc);
        if (tid == 127) sc[2] = b;
        __syncthreads();
        const float bL = sc[2];
        const float g = tid < 128 ? bL - b + iv : -INFINITY;
        const float gm_w = wave_max(g);
        if (lane == 0 && wave < 2) sc[4 + wave] = gm_w;
        __syncthreads();
        const float gmax = fmaxf(sc[4], sc[5]);
        if (tid < 128) wv[tid] = fexp(g - gmax) * KSCALE_M;
        if (tid == 0) { BL[u] = bL; GMAX[u] = gmax; }
        __syncthreads();
        stage_T<true>(KM + (size_t)t0 * 512 + 128 * h, 512, KWT, wv, tid);
        stage_T<false>(VM + (size_t)t0 * 512 + 128 * h, 512, VTX, wv, tid);
        fill_ext_rows(VTX, (bf16)0x3F80, tid);
        __syncthreads();
        const int fr = lane & 15, fq = lane >> 4;
        float* out = DCT + (size_t)u * SELEM;
#pragma unroll 1
        for (int pass = 0; pass < 2; ++pass) {
            if (pass == 1 && wave != 0) break;
            const int et = pass == 0 ? wave : 8;
            pg8::f32x4 acc[8];
#pragma unroll
            for (int dt = 0; dt < 8; ++dt) acc[dt] = (pg8::f32x4){0.f, 0.f, 0.f, 0.f};
#pragma unroll
            for (int kk = 0; kk < 4; ++kk) { const bf16x8 a = *(const LAS bf16x8*)(VTX + (16 * et + fr) * TP + 32 * kk + 8 * fq);
#pragma unroll
                for (int dt = 0; dt < 8; ++dt) { const bf16x8 bb = *(const LAS bf16x8*)(KWT + (16 * dt + fr) * TP + 32 * kk + 8 * fq); acc[dt] = MFMA16(a, bb, acc[dt]); } }
#pragma unroll
            for (int dt = 0; dt < 8; ++dt)
#pragma unroll
                for (int r = 0; r < 4; ++r) { const int e = 16 * et + 4 * fq + r; if (e <= 128) out[(size_t)e * 128 + 16 * dt + fr] = acc[dt][r]; }
        }
    }
    __syncthreads();
}

__device__ __forceinline__ void mscan_phase(Frame& F, const float* DCT, const float* BL, const float* GMAX, bf16* STATE, float* MST) {
    LAS float* sa = (LAS float*)(F.lds + RING_OFF); LAS float* sb = sa + 512;
    const int tid = F.tid;
    __syncthreads();
    if (tid < 4) { const int h = tid; float m = 0.f;
        for (int c = 0; c < NCHUNK; ++c) { const float bl = BL[c * 4 + h], gm = GMAX[c * 4 + h]; const float mn = fmaxf(bl + m, gm);
            sa[c * 4 + h] = fexp(bl + m - mn); sb[c * 4 + h] = fexp(gm - mn); if (F.bid == 0) MST[c * 4 + h] = m; m = mn; } }
    __syncthreads();
    for (int g = F.bid * (NWAVES * 64) + tid; g < 4 * SELEM; g += F.G * NWAVES * 64) {
        const int h = g / SELEM, idx = g % SELEM; float S = 0.f;
        const float* dp = DCT + (size_t)h * SELEM + idx; bf16* sp = STATE + (size_t)h * SELEM + idx;
#pragma unroll 1
        for (int c0 = 0; c0 < NCHUNK; c0 += 8) {
            float dv[8];
#pragma unroll
            for (int j = 0; j < 8; ++j) dv[j] = dp[(size_t)(c0 + j) * 4 * SELEM];
#pragma unroll
            for (int j = 0; j < 8; ++j) { sp[(size_t)(c0 + j) * 4 * SELEM] = (bf16)(cvtpk(S, 0.f) & 0xffffu); S = sa[(c0 + j) * 4 + h] * S + sb[(c0 + j) * 4 + h] * dv[j]; }
        }
    }
    __syncthreads();
}

__device__ __forceinline__ bf16x8 scale_frag(const bf16x8 q, float w) {
    const v4u v = __builtin_bit_cast(v4u, q); v4u o;
    o.x = cvtpk(bflo(v.x) * w, bfhi(v.x) * w); o.y = cvtpk(bflo(v.y) * w, bfhi(v.y) * w); o.z = cvtpk(bflo(v.z) * w, bfhi(v.z) * w); o.w = cvtpk(bflo(v.w) * w, bfhi(v.w) * w);
    return __builtin_bit_cast(bf16x8, o);
}
__device__ __forceinline__ void mout_phase(Frame& F, const bf16* qkvm, const bf16* proj, const float* IG, const float* FG, const bf16* STATE, const float* MST, const float* gn  , bf16* Y) {
    LAS bf16* KS = (LAS bf16*)(F.lds + RING_OFF + MO_KS); LAS bf16* VTX = (LAS bf16*)(F.lds + RING_OFF + MO_VTX); LAS bf16* CTX = (LAS bf16*)(F.lds + RING_OFF + MO_CTX);
    LAS float* sc = (LAS float*)(F.lds + RING_OFF + MO_SC); LAS float* ub = sc + 16; LAS float* Ml = sc + 16 + 128; LAS float* bbs = sc + 16 + 256;
    const int tid = F.tid, lane = F.lane, wave = F.wave, fr = lane & 15, fq = lane >> 4;
    const bf16* QM = qkvm; const bf16* KM = qkvm + (size_t)M * 512; const bf16* VM = qkvm + (size_t)2 * M * 512;
    for (int u = F.bid; u < NCHUNK * 4; u += F.G) {
        const int c = u >> 2, h = u & 3, t0 = 128 * c;
        __syncthreads();
        float fv = 0.f, iv = 0.f;
        if (tid < 128) { fv = FG[(size_t)(t0 + tid) * 4 + h]; iv = IG[(size_t)(t0 + tid) * 4 + h]; }
        const float b = scan128_add(fv, tid, lane, wave, sc);
        const float uu = tid < 128 ? iv - b : -INFINITY;
        const float U = scan128_max(uu, tid, lane, wave, sc);
        const float mst = MST[u];
        if (tid < 128) { ub[tid] = uu; Ml[tid] = fmaxf(mst, U); bbs[tid] = b; }
        { const int piece = tid & 15, s0 = tid >> 4;
#pragma unroll
          for (int it = 0; it < 4; ++it) { const int s = s0 + 32 * it;
              *(LAS v4u*)(KS + s * TP + piece * 8) = *(const GAS v4u*)(KM + (size_t)(t0 + s) * 512 + 128 * h + piece * 8);
              *(LAS v4u*)(CTX + s * TP + piece * 8) = *(const GAS v4u*)(STATE + (size_t)u * SELEM + (size_t)s * 128 + piece * 8); }
          if (tid < 16) *(LAS v4u*)(CTX + 128 * TP + tid * 8) = *(const GAS v4u*)(STATE + (size_t)u * SELEM + (size_t)128 * 128 + tid * 8);
          for (int idx = tid; idx < 15 * 128; idx += NWAVES * 64) CTX[(129 + (idx >> 7)) * TP + (idx & 127)] = (bf16)0; }
        stage_T<false>(VM + (size_t)t0 * 512 + 128 * h, 512, VTX, ub, tid);
        fill_ext_rows(VTX, (bf16)0x3F80, tid);
        bf16x8 qf[4];
        const size_t qrow = (size_t)(t0 + 16 * wave + fr);
#pragma unroll
        for (int kk = 0; kk < 4; ++kk) qf[kk] = *(const GAS bf16x8*)(QM + qrow * 512 + 128 * h + 32 * kk + 8 * fq);
        __syncthreads();
        pg8::f32x4 sacc[8];
#pragma unroll
        for (int st = 0; st < 8; ++st) { sacc[st] = (pg8::f32x4){0.f, 0.f, 0.f, 0.f};
            if (st <= wave) {
#pragma unroll
                for (int kk = 0; kk < 4; ++kk) { const bf16x8 kb = *(const LAS bf16x8*)(KS + (16 * st + fr) * TP + 32 * kk + 8 * fq); sacc[st] = MFMA16(qf[kk], kb, sacc[st]); } } }
        float Mr[4], br[4];
#pragma unroll
        for (int r = 0; r < 4; ++r) { Mr[r] = Ml[16 * wave + 4 * fq + r]; br[r] = bbs[16 * wave + 4 * fq + r]; }
        const float iw = fexp(mst - Ml[16 * wave + fr]);
        __syncthreads();
#pragma unroll
        for (int st = 0; st < 8; ++st) {
            if (st <= (wave | 1)) { const int s = 16 * st + fr; const float us = ub[s];
#pragma unroll
                for (int r = 0; r < 4; ++r) { const int l = 16 * wave + 4 * fq + r; float v = 0.f;
                    if (st <= wave && s <= l) v = sacc[st][r] * KSCALE_M * fexp(us - Mr[r]);
                    KS[l * TP + s] = (bf16)(cvtpk(v, 0.f) & 0xffffu); } } }
        __syncthreads();
        pg8::f32x4 acc[9];
#pragma unroll
        for (int et = 0; et < 9; ++et) acc[et] = (pg8::f32x4){0.f, 0.f, 0.f, 0.f};
#pragma unroll
        for (int kk = 0; kk < 4; ++kk) {
            if (kk <= (wave >> 1)) { const bf16x8 a = *(const LAS bf16x8*)(KS + (16 * wave + fr) * TP + 32 * kk + 8 * fq);
#pragma unroll
                for (int et = 0; et < 9; ++et) { const bf16x8 vb = *(const LAS bf16x8*)(VTX + (16 * et + fr) * TP + 32 * kk + 8 * fq); acc[et] = MFMA16(a, vb, acc[et]); } } }
#pragma unroll
        for (int kk = 0; kk < 4; ++kk) { const bf16x8 a = scale_frag(qf[kk], iw);
#pragma unroll
            for (int et = 0; et < 9; ++et) { const bf16x8 cb = *(const LAS bf16x8*)(CTX + (16 * et + fr) * TP + 32 * kk + 8 * fq); acc[et] = MFMA16(a, cb, acc[et]); } }
#pragma unroll
        for (int r = 0; r < 4; ++r) {
            const float nq = __shfl(acc[8][r], lane & 48);
            const float den = fmaxf(fabsf(nq), fexp(-br[r] - Mr[r]));
            const float rden = 1.0f / den;
            float hv[8], s1 = 0.f;
#pragma unroll
            for (int et = 0; et < 8; ++et) { hv[et] = acc[et][r] * rden; s1 += hv[et]; }
            s1 += __shfl_xor(s1, 1); s1 += __shfl_xor(s1, 2); s1 += __shfl_xor(s1, 4); s1 += __shfl_xor(s1, 8);
            const float mean = s1 * (1.0f / 128.0f); float s2 = 0.f;
#pragma unroll
            for (int et = 0; et < 8; ++et) { hv[et] -= mean; s2 += hv[et] * hv[et]; }
            s2 += __shfl_xor(s2, 1); s2 += __shfl_xor(s2, 2); s2 += __shfl_xor(s2, 4); s2 += __shfl_xor(s2, 8);
            const float rstd = 1.0f / sqrtf(s2 * (1.0f / 128.0f) + LN_EPS);
            const size_t t = (size_t)(t0 + 16 * wave + 4 * fq + r);
#pragma unroll
            for (int et = 0; et < 8; ++et) { const int e = 16 * et + fr; const float z = bf2f(proj[t * PP + 2048 + 128 * h + e]);
                const float o = hv[et] * rstd * gn[128 * h + e] * z;
                Y[t * D + 512 + 128 * h + e] = (bf16)(cvtpk(o, 0.f) & 0xffffu); }
        }
    }
    __syncthreads();
}

__device__ __forceinline__ void ln_phase(Frame& F, const float* xold, const float* y0, const float* y1, const float* g, const float* b, float* xnew, bf16* xb) {
    const int gw = F.vcu * NWAVES + F.wave, NGW = F.G * NWAVES, lane = F.lane;
    f32x4 gv[4], bv[4];
#pragma unroll
    for (int j = 0; j < 4; ++j) { gv[j] = ((const GAS f32x4*)g)[lane + 64 * j]; bv[j] = ((const GAS f32x4*)b)[lane + 64 * j]; }
    for (int m = gw; m < M; m += NGW) {
        const GAS f32x4* xr = (const GAS f32x4*)(xold + (size_t)m * D) + lane; const GAS f32x4* yr = (const GAS f32x4*)(y0 + (size_t)m * D) + lane;
        f32x4 v[4]; float s = 0.f;
#pragma unroll
        for (int j = 0; j < 4; ++j) { v[j] = xr[64 * j] * ALPHA + yr[64 * j]; }
        if (y1) { const GAS f32x4* zr = (const GAS f32x4*)(y1 + (size_t)m * D) + lane;
#pragma unroll
            for (int j = 0; j < 4; ++j) v[j] = v[j] + zr[64 * j]; }
#pragma unroll
        for (int j = 0; j < 4; ++j) s += (v[j].x + v[j].y) + (v[j].z + v[j].w);
        const float mean = wave_sum(s) * (1.f / D); float s2 = 0.f;
#pragma unroll
        for (int j = 0; j < 4; ++j) { v[j] = v[j] - mean; s2 += (v[j].x * v[j].x + v[j].y * v[j].y) + (v[j].z * v[j].z + v[j].w * v[j].w); }
        const float rstd = 1.f / sqrtf(wave_sum(s2) * (1.f / D) + LN_EPS);
        GAS f32x4* o4 = (GAS f32x4*)(xnew + (size_t)m * D) + lane;
#pragma unroll
        for (int j = 0; j < 4; ++j) { v[j] = v[j] * rstd * gv[j] + bv[j]; o4[64 * j] = v[j]; }
        if (xb) { GAS unsigned long long* o8 = (GAS unsigned long long*)(xb + (size_t)m * D) + lane;
#pragma unroll
            for (int j = 0; j < 4; ++j) o8[64 * j] = (unsigned long long)cvtpk(v[j].x, v[j].y) | ((unsigned long long)cvtpk(v[j].z, v[j].w) << 32); }
    }
}

__device__ __forceinline__ void router_phase(Frame& F, const float* x1, const float* rw  , const float* rb  , int* TOPI, float* TOPW, int* HIST) {
    const int lane = F.lane, wave = F.wave, tid = F.tid;
    LAS int* cnt = (LAS int*)(F.lds + RING_OFF);
    float w[16][8];
#pragma unroll
    for (int j = 0; j < 4; ++j)
#pragma unroll
        for (int i = 0; i < 4; ++i) { const GAS f32x4* wp = (const GAS f32x4*)(rw + (size_t)(4 * lane + 256 * j + i) * 8); const f32x4 w0 = wp[0], w1 = wp[1];
            w[4 * j + i][0] = w0.x; w[4 * j + i][1] = w0.y; w[4 * j + i][2] = w0.z; w[4 * j + i][3] = w0.w; w[4 * j + i][4] = w1.x; w[4 * j + i][5] = w1.y; w[4 * j + i][6] = w1.z; w[4 * j + i][7] = w1.w; }
    for (int blk = F.bid; blk < M / 64; blk += F.G) {
        __syncthreads();
        if (tid < 8) cnt[tid] = 0;
        __syncthreads();
#pragma unroll 1
        for (int tt = 0; tt < 8; ++tt) { const int t = blk * 64 + wave * 8 + tt;
            const GAS f32x4* xr = (const GAS f32x4*)(x1 + (size_t)t * D) + lane; float acc[8];
#pragma unroll
            for (int e = 0; e < 8; ++e) acc[e] = 0.f;
#pragma unroll
            for (int j = 0; j < 4; ++j) { const f32x4 xv = xr[64 * j];
#pragma unroll
                for (int e = 0; e < 8; ++e) acc[e] += xv.x * w[4 * j + 0][e] + xv.y * w[4 * j + 1][e] + xv.z * w[4 * j + 2][e] + xv.w * w[4 * j + 3][e]; }
            float lg[8];
#pragma unroll
            for (int e = 0; e < 8; ++e) lg[e] = wave_sum(acc[e]) + rb[e];
            int i1 = 0; float v1 = lg[0];
#pragma unroll
            for (int e = 1; e < 8; ++e) if (lg[e] > v1) { v1 = lg[e]; i1 = e; }
            int i2 = -1; float v2 = -INFINITY;
#pragma unroll
            for (int e = 0; e < 8; ++e) if (e != i1 && lg[e] > v2) { v2 = lg[e]; i2 = e; }
            const float ex = __expf(v2 - v1), w1 = 1.0f / (1.0f + ex), w2 = ex * w1;
            if (lane == 0) { TOPI[t] = i1 | (i2 << 8); TOPW[2 * t] = w1; TOPW[2 * t + 1] = w2; __hip_atomic_fetch_add(&cnt[i1], 1, __ATOMIC_RELAXED, __HIP_MEMORY_SCOPE_WORKGROUP); __hip_atomic_fetch_add(&cnt[i2], 1, __ATOMIC_RELAXED, __HIP_MEMORY_SCOPE_WORKGROUP); }
        }
        __syncthreads();
        if (tid < 8) HIST[blk * 8 + tid] = cnt[tid];
    }
    __syncthreads();
}
__device__ __forceinline__ void gather_phase(Frame& F, const bf16* xb, const int* TOPI, const float* TOPW, const int* HIST, int* TSEG, int* ROWTOK, float* ROWW, bf16* XG) {
    const int lane = F.lane, wave = F.wave, tid = F.tid;
    LAS int* tot = (LAS int*)(F.lds + RING_OFF); LAS int* pre = tot + 8; LAS int* seg = tot + 16; LAS int* rowof = tot + 32;
    for (int blk = F.bid; blk < M / 64; blk += F.G) {
        __syncthreads();
        {
            const int e = wave; int t = 0, p = 0;
#pragma unroll
            for (int j = 0; j < 4; ++j) { const int bb = lane + 64 * j; const int hv = HIST[bb * 8 + e]; t += hv; if (bb < blk) p += hv; }
#pragma unroll
            for (int o = 1; o < 64; o <<= 1) { t += __shfl_xor(t, o); p += __shfl_xor(p, o); }
            if (lane == 0) { tot[e] = t; pre[e] = p; }
        }
        __syncthreads();
        if (tid == 0) { int s = 0; for (int e = 0; e < 8; ++e) { seg[e] = s; s += (tot[e] + 255) & ~255; } seg[8] = s; }
        __syncthreads();
        {
            const int e = wave, t = blk * 64 + lane; const int ti = TOPI[t]; const int i1 = ti & 0xff, i2 = (ti >> 8) & 0xff;
            const bool f = (i1 == e) || (i2 == e); const unsigned long long bal = __ballot(f);
            if (f) { const int slot = (i1 == e) ? 0 : 1; const int rho = seg[e] + pre[e] + __popcll(bal & ((1ull << lane) - 1ull));
                ROWTOK[rho] = t | (slot << 16); ROWW[rho] = TOPW[2 * t + slot]; rowof[lane * 2 + slot] = rho; }
        }
        __syncthreads();
#pragma unroll 1
        for (int k = 0; k < 16; ++k) { const int pr = wave * 16 + k, tk = pr >> 1; const int rho = rowof[pr];
            const GAS v4u* src = (const GAS v4u*)(xb + (size_t)(blk * 64 + tk) * D) + lane; GAS v4u* dst = (GAS v4u*)(XG + (size_t)rho * D) + lane;
            dst[0] = src[0]; dst[64] = src[64]; }
        if (blk < 8) { const int e = blk; const int n = tot[e], lo = seg[e] + n, hi = seg[e + 1];
            for (int r = lo + wave; r < hi; r += NWAVES) { GAS v4u* dst = (GAS v4u*)(XG + (size_t)r * D) + lane; dst[0] = (v4u){0u, 0u, 0u, 0u}; dst[64] = (v4u){0u, 0u, 0u, 0u}; if (lane == 0) { ROWTOK[r] = -1; ROWW[r] = 0.f; } } }
        if (blk == 0 && tid < 9) TSEG[tid] = seg[tid] >> 8;
    }
    __syncthreads();
}

struct Args { const float* in[23]; float* out; unsigned char* ws; int layer, pad; };
static_assert(sizeof(Args) == 25 * 8 + 8, "Args has no padding");
#define PG8_SP2 true
#define PG8_ALIGN true
enum PhaseKind { PK_PROLOGUE = 0, PK_GEMM1, PK_CONV, PK_QKVM, PK_GATES_ATTN, PK_MLOCAL, PK_MSCAN_COMBINE, PK_MOUT, PK_MERGE, PK_WO, PK_LN1, PK_FFN_UP, PK_FFN_DOWN, PK_LN2, PK_ROUTER, PK_GATHER, PK_MOE_UP, PK_MOE_DOWN, PK_LN3, PK_COUNT };

template <int KIND>
__device__ __forceinline__ void run_phase(Frame& F, const Args& args, const int l) {
    unsigned char* ws = args.ws; const float* const* in = args.in; LAS unsigned char* ring = F.lds + RING_OFF;
    bf16* XB = (bf16*)(ws + WS_XB); bf16* PROJ = (bf16*)(ws + WS_PROJ); bf16* GATE = (bf16*)(ws + WS_GATE); bf16* QKVM = (bf16*)(ws + WS_QKVM);
    bf16* OP = (bf16*)(ws + WS_OP); float* LSE = (float*)(ws + WS_LSE); bf16* Y = (bf16*)(ws + WS_Y); float* DCT = (float*)(ws + WS_DCT); bf16* STATE = (bf16*)(ws + WS_STATE);
    float* IG = (float*)(ws + WS_SMALL); float* FG = (float*)(ws + WS_SMALL + 256 * 1024); float* BL = (float*)(ws + WS_SMALL + 512 * 1024); float* GMAX = (float*)(ws + WS_SMALL + 516 * 1024); float* MST = (float*)(ws + WS_SMALL + 520 * 1024);
    bf16* MERGED = (bf16*)(ws + WS_MERGED); float* YF = (float*)(ws + WS_YF); float* X1F = (float*)(ws + WS_X1F); float* X2F = (float*)(ws + WS_X2F);
    int* TOPI = (int*)(ws + WS_ROUTE); float* TOPW = (float*)(ws + WS_ROUTE + 64 * 1024); int* HIST = (int*)(ws + WS_ROUTE + 192 * 1024); int* TSEG = (int*)(ws + WS_ROUTE + 200 * 1024);
    int* ROWTOK = (int*)(ws + WS_ROUTE + 256 * 1024); float* ROWW = (float*)(ws + WS_ROUTE + 512 * 1024);
    bf16* XG = (bf16*)(ws + WS_XG); bf16* HH = (bf16*)(ws + WS_HH); float* YE = (float*)(ws + WS_YE);
    const char* w1t = (const char*)(ws + WS_W1T + l * W1T_L); const char* wbr = (const char*)(ws + WS_WBR + l * WBR_L); const char* wot = (const char*)(ws + WS_WOT + l * WOT_L); const char* wqkv = (const char*)(ws + WS_WQKV + l * WQKV_L);
    if constexpr (KIND == PK_PROLOGUE) p0_prologue(F, in, ws);
    if constexpr (KIND == PK_GEMM1) { const pg8::Gemm g{D, D, D}; const SchedGrid S{64, 18, F.G, F.bid, (const char*)XB, w1t, (size_t)256 * D * 2, (size_t)256 * D * 2};
        const pg8::EpiProj E{PROJ, GATE, in[4] + l * NGATE, QSCALE};
        pg8::gemm_phase<pg8::EpiProj, SchedGrid, PG8_ALIGN, PG8_SP2>(ring, g, S, E); }
    if constexpr (KIND == PK_CONV) conv_phase(F, PROJ, in[5] + l * 4 * 512, in[6] + l * 512);
    if constexpr (KIND == PK_QKVM) { const pg8::Gemm g{PP, 256, 256}; const SchedQkvM S{F.G, F.bid, (const char*)PROJ, wqkv};
        const pg8::EpiBf16Sel E{QKVM, (size_t)M * 512, 512};
        pg8::gemm_phase<pg8::EpiBf16Sel, SchedQkvM, PG8_ALIGN, PG8_SP2>(ring, g, S, E); }
    if constexpr (KIND == PK_GATES_ATTN) { gates_phase(F, QKVM, in[9] + l * 1536 * 8, in[10] + l * 8, IG, FG); attn_phase(F, PROJ, OP, LSE, in[1]); }
    if constexpr (KIND == PK_MLOCAL) mlocal_phase(F, QKVM, IG, FG, DCT, BL, GMAX);
    if constexpr (KIND == PK_MSCAN_COMBINE) { mscan_phase(F, DCT, BL, GMAX, STATE, MST); combine_phase(F, OP, LSE, Y); }
    if constexpr (KIND == PK_MOUT) mout_phase(F, QKVM, PROJ, IG, FG, STATE, MST, in[11] + l * 512, Y);
    if constexpr (KIND == PK_MERGE) { const pg8::Gemm g{D, D, 512}; const SchedMerge S{F.G, F.bid, (const char*)Y, wbr};
        const pg8::EpiMerge E{MERGED, GATE};
        pg8::gemm_phase<pg8::EpiMerge, SchedMerge, PG8_ALIGN, PG8_SP2>(ring, g, S, E); }
    if constexpr (KIND == PK_WO) { const pg8::Gemm g{D, D, D}; const SchedGrid S{64, 4, F.G, F.bid, (const char*)MERGED, wot, (size_t)256 * D * 2, (size_t)256 * D * 2};
        const pg8::EpiF32 E{YF, D};
        pg8::gemm_phase<pg8::EpiF32, SchedGrid, PG8_ALIGN, PG8_SP2>(ring, g, S, E); }
    if constexpr (KIND == PK_LN1) ln_phase(F, l == 0 ? in[0] : X2F, YF, nullptr, in[15] + (l * 2 + 0) * D, in[16] + (l * 2 + 0) * D, X1F, XB);
    if constexpr (KIND == PK_FFN_UP) { const pg8::Gemm g{D, D, D}; const SchedGrid S{64, 22, F.G, F.bid, (const char*)XB, (const char*)(ws + WS_W13T), (size_t)256 * D * 2, (size_t)256 * D * 2};
        const pg8::EpiSwiglu E{(bf16*)(ws + WS_H), FF};
        pg8::gemm_phase<pg8::EpiSwiglu, SchedGrid, PG8_ALIGN, PG8_SP2>(ring, g, S, E); }
    if constexpr (KIND == PK_FFN_DOWN) { const pg8::Gemm g{FF, FF, FF}; const SchedGrid S{64, 4, F.G, F.bid, (const char*)(ws + WS_H), (const char*)(ws + WS_W2T), (size_t)256 * FF * 2, (size_t)256 * FF * 2};
        const pg8::EpiF32 E{YF, D};
        pg8::gemm_phase<pg8::EpiF32, SchedGrid, PG8_ALIGN, PG8_SP2>(ring, g, S, E); }
    if constexpr (KIND == PK_LN2) ln_phase(F, X1F, YF, nullptr, in[15] + (l * 2 + 1) * D, in[16] + (l * 2 + 1) * D, X2F, XB);
    if constexpr (KIND == PK_ROUTER) router_phase(F, X1F, in[19], in[20], TOPI, TOPW, HIST);
    if constexpr (KIND == PK_GATHER) gather_phase(F, XB, TOPI, TOPW, HIST, TSEG, ROWTOK, ROWW, XG);
    if constexpr (KIND == PK_MOE_UP) { const pg8::Gemm g{D, D, D}; SchedMoe S; S.nN = 28; S.G = F.G; S.c = F.bid;
#pragma unroll
        for (int j = 0; j < 9; ++j) S.tseg[j] = __builtin_amdgcn_readfirstlane(TSEG[j]);
        S.A = (const char*)XG; S.B = (const char*)(ws + WS_EW13T); S.astep = (size_t)256 * D * 2; S.bstep = (size_t)256 * D * 2; S.estep = EW13T_E;
        const pg8::EpiSwiglu E{HH, FE};
        pg8::gemm_phase<pg8::EpiSwiglu, SchedMoe, PG8_ALIGN, PG8_SP2>(ring, g, S, E); }
    if constexpr (KIND == PK_MOE_DOWN) { const pg8::Gemm g{FE, FE, FE}; SchedMoe S; S.nN = 4; S.G = F.G; S.c = F.bid;
#pragma unroll
        for (int j = 0; j < 9; ++j) S.tseg[j] = __builtin_amdgcn_readfirstlane(TSEG[j]);
        S.A = (const char*)HH; S.B = (const char*)(ws + WS_EW2T); S.astep = (size_t)256 * FE * 2; S.bstep = (size_t)256 * FE * 2; S.estep = EW2T_E;
        const pg8::EpiScatter E{YE, ROWTOK, ROWW, M};
        pg8::gemm_phase<pg8::EpiScatter, SchedMoe, PG8_ALIGN, PG8_SP2>(ring, g, S, E); }
    if constexpr (KIND == PK_LN3) ln_phase(F, X1F, YE, YE + (size_t)M * D, in[15] + (l * 2 + 1) * D, in[16] + (l * 2 + 1) * D, args.out, nullptr);
}

__device__ __forceinline__ void make_frame(Frame& F, unsigned char* lds, unsigned char* ws) {
    F.lds = (LAS unsigned char*)lds;
    F.MISC = (volatile LAS unsigned*)(F.lds + MISC_OFF);
    F.tid = threadIdx.x; F.lane = F.tid & 63; F.wave = __builtin_amdgcn_readfirstlane(F.tid >> 6);
    F.G = gridDim.x; F.bid = blockIdx.x; { const int bx = blockIdx.x; F.vcu = (F.G % 8 == 0) ? (bx % 8) * (F.G / 8) + bx / 8 : bx; }
    F.ctl = (gu32*)(ws + WS_CTL);
}

template <int KIND>
__global__ void __launch_bounds__(NWAVES * 64, 2) phase_kernel(Args args) {
    extern __shared__ __attribute__((aligned(16))) unsigned char lds[];
    Frame F; make_frame(F, lds, args.ws);
    run_phase<KIND>(F, args, args.layer);
}

template <int KIND> static void launch_phase(int grid, hipStream_t stream, Args a, int layer) {
    static bool attr = false;
    if (!attr) { (void)hipFuncSetAttribute((const void*)phase_kernel<KIND>, hipFuncAttributeMaxDynamicSharedMemorySize, LDS_BYTES); attr = true; }
    a.layer = layer; a.pad = 0;
    hipLaunchKernelGGL(phase_kernel<KIND>, dim3(grid), dim3(NWAVES * 64), LDS_BYTES, stream, a);
}
extern "C" void kernel_launch(void* const* d_in, const int* in_sizes, int n_in, void* d_out, int out_size, void* d_ws, size_t ws_size, hipStream_t stream) {
    static int grid = 0;
    if (grid == 0) {
        if (n_in != 23 || in_sizes[0] != M * D || out_size != M * D || ws_size < WS_END) { fprintf(stderr, "kernel_launch: built for 23 inputs, x/out of %d floats, >= %zu bytes of workspace; got n_in %d, in0 %d, out %d, ws %zu; nothing launched\n", M * D, (size_t)WS_END, n_in, n_in > 0 ? in_sizes[0] : -1, out_size, ws_size); grid = -1; return; }
        int dev = 0, cus = 0;
        if (hipGetDevice(&dev) != hipSuccess || hipDeviceGetAttribute(&cus, hipDeviceAttributeMultiprocessorCount, dev) != hipSuccess) { fprintf(stderr, "kernel_launch: device query failed\n"); grid = -1; return; }
        grid = cus;
    }
    if (grid < 0) return;
    if (hipMemsetAsync((char*)d_ws + WS_CTL, 0, CTL_ZERO_BYTES, stream) != hipSuccess) { fprintf(stderr, "kernel_launch: hipMemsetAsync failed\n"); return; }
    Args a{};
    for (int i = 0; i < 23; ++i) a.in[i] = (const float*)d_in[i];
    a.out = (float*)d_out; a.ws = (unsigned char*)d_ws;
    launch_phase<PK_PROLOGUE>(grid, stream, a, 0);
    for (int l = 0; l < 2; ++l) {
        launch_phase<PK_GEMM1>(grid, stream, a, l); launch_phase<PK_CONV>(grid, stream, a, l); launch_phase<PK_QKVM>(grid, stream, a, l); launch_phase<PK_GATES_ATTN>(grid, stream, a, l);
        launch_phase<PK_MLOCAL>(grid, stream, a, l); launch_phase<PK_MSCAN_COMBINE>(grid, stream, a, l); launch_phase<PK_MOUT>(grid, stream, a, l); launch_phase<PK_MERGE>(grid, stream, a, l);
        launch_phase<PK_WO>(grid, stream, a, l); launch_phase<PK_LN1>(grid, stream, a, l);
        if (l == 0) { launch_phase<PK_FFN_UP>(grid, stream, a, l); launch_phase<PK_FFN_DOWN>(grid, stream, a, l); launch_phase<PK_LN2>(grid, stream, a, l); }
        else { launch_phase<PK_ROUTER>(grid, stream, a, l); launch_phase<PK_GATHER>(grid, stream, a, l); launch_phase<PK_MOE_UP>(grid, stream, a, l); launch_phase<PK_MOE_DOWN>(grid, stream, a, l); launch_phase<PK_LN3>(grid, stream, a, l); }
    }
    const hipError_t le = hipPeekAtLastError();
    if (le != hipSuccess) fprintf(stderr, "kernel_launch: launch failed: %s\n", hipGetErrorName(le));
}
```
